# Optimizing an MI355X kernel written in HIP

```python
import jax, jax.numpy as jnp
from jax import lax
import numpy as np

D_MODEL = 1024
BATCH = 2
SEQ = 8192
DEPTH = 1

N_META = 16
N_HEADS = 8
N_KV_HEADS = 2
HEAD_DIM = 128
Q_PER_KV = N_HEADS // N_KV_HEADS
ATTN_WIDTH = N_HEADS * HEAD_DIM
KV_WIDTH = N_KV_HEADS * HEAD_DIM
WINDOW = 128
BLOCK = 128
LRU_WIDTH = D_MODEL
LRU_BLOCKS = 8
LRU_BLOCK_DIM = LRU_WIDTH // LRU_BLOCKS
CONV_WIDTH = 4
LRU_C = 8.0
N_GROUPS = 4
EXPERTS_PER_GROUP = 4
N_EXPERTS = N_GROUPS * EXPERTS_PER_GROUP
TOP_K = 2
EXPERT_FF = 512
N_BRANCHES = 2
IN_WIDTH = ATTN_WIDTH + 2 * KV_WIDTH + 2 * LRU_WIDTH + N_BRANCHES * D_MODEL
IN_SPLITS = (ATTN_WIDTH, ATTN_WIDTH + KV_WIDTH, ATTN_WIDTH + 2 * KV_WIDTH,
             ATTN_WIDTH + 2 * KV_WIDTH + LRU_WIDTH, ATTN_WIDTH + 2 * KV_WIDTH + 2 * LRU_WIDTH)
EPS = 1e-6
NEG_INF = -1e30

kernel_name = 'hybrid_rglru_swa_hmoe_encoder_block'


def rms_norm(x, g):
    xf = x.astype(jnp.float32)
    y = xf * lax.rsqrt(jnp.mean(xf * xf, axis=-1, keepdims=True) + EPS)
    return (y * g.astype(jnp.float32)).astype(x.dtype)


def alibi_slopes():
    return jnp.exp2(-8.0 * (jnp.arange(N_HEADS, dtype=jnp.float32) + 1.0) / N_HEADS)


def banded_window_attention(q, k, v, sink):
    batch, t_len = q.shape[0], q.shape[1]
    lead = BLOCK - N_META
    p_len = t_len + lead
    nb = p_len // BLOCK
    pad = ((0, 0), (lead, 0), (0, 0), (0, 0))
    qb = jnp.pad(q, pad).reshape(batch, nb, BLOCK, N_KV_HEADS, Q_PER_KV, HEAD_DIM)

    def band(z):
        zb = jnp.pad(z, pad).reshape(batch, nb, BLOCK, N_KV_HEADS, HEAD_DIM)
        zb = jnp.pad(zb, ((0, 0), (1, 1), (0, 0), (0, 0), (0, 0)))
        return jnp.concatenate([zb[:, :-2], zb[:, 1:-1], zb[:, 2:]], axis=2)

    kb, vb = band(k), band(v)
    blk = jnp.arange(nb)[:, None]
    q_pos = blk * BLOCK + jnp.arange(BLOCK)[None, :] - lead
    k_idx = (blk - 1) * BLOCK + jnp.arange(3 * BLOCK)[None, :]
    k_pos = k_idx - lead
    k_ok = (k_pos >= N_META) & (k_idx < p_len)
    dist = jnp.abs(q_pos[:, :, None] - k_pos[:, None, :])
    band_ok = (dist <= WINDOW) & k_ok[:, None, :]
    scale = HEAD_DIM ** -0.5
    slopes = alibi_slopes().reshape(N_KV_HEADS, Q_PER_KV)
    s_band = jnp.einsum('bnqkgd,bnskd->bnkgqs', qb, kb, preferred_element_type=jnp.float32) * scale
    s_band = s_band - slopes[None, None, :, :, None, None] * dist.astype(jnp.float32)[None, :, None, None]
    s_band = jnp.where(band_ok[None, :, None, None], s_band, NEG_INF)
    k_meta, v_meta = k[:, :N_META], v[:, :N_META]
    s_meta = jnp.einsum('bnqkgd,bmkd->bnkgqm', qb, k_meta, preferred_element_type=jnp.float32) * scale
    s_sink = jnp.broadcast_to(sink.astype(jnp.float32).reshape(1, 1, N_KV_HEADS, Q_PER_KV, 1, 1),
                              s_band.shape[:-1] + (1,))
    probs = jax.nn.softmax(jnp.concatenate([s_band, s_meta, s_sink], axis=-1), axis=-1).astype(v.dtype)
    out = (jnp.einsum('bnkgqs,bnskd->bnqkgd', probs[..., :3 * BLOCK], vb)
           + jnp.einsum('bnkgqm,bmkd->bnqkgd', probs[..., 3 * BLOCK:3 * BLOCK + N_META], v_meta))
    return out.reshape(batch, p_len, ATTN_WIDTH)[:, lead:]


def centred_depthwise_conv(x, w, b):
    y = lax.conv_general_dilated(x, w[:, None, :].astype(x.dtype), window_strides=(1,),
                                 padding=[(CONV_WIDTH // 2, CONV_WIDTH - 1 - CONV_WIDTH // 2)],
                                 dimension_numbers=('NWC', 'WIO', 'NWC'),
                                 feature_group_count=x.shape[-1])
    return y + b


def linear_combine(left, right):
    a1, b1 = left
    a2, b2 = right
    return a1 * a2, a2 * b1 + b2


def rg_lru(xc, w_a, b_a, w_x, b_x, lam, reverse):
    batch, t_len = xc.shape[0], xc.shape[1]
    xb = xc.reshape(batch, t_len, LRU_BLOCKS, LRU_BLOCK_DIM)
    r = jax.nn.sigmoid((jnp.einsum('btnd,nde->btne', xb, w_a).reshape(batch, t_len, LRU_WIDTH) + b_a).astype(jnp.float32))
    i = jax.nn.sigmoid((jnp.einsum('btnd,nde->btne', xb, w_x).reshape(batch, t_len, LRU_WIDTH) + b_x).astype(jnp.float32))
    log_a = -LRU_C * r * jax.nn.softplus(-lam.astype(jnp.float32))
    a = jnp.exp(log_a)
    u = jnp.sqrt(-jnp.expm1(2.0 * log_a)) * (i * xc.astype(jnp.float32))
    _, h = lax.associative_scan(linear_combine, (a, u), axis=1, reverse=reverse)
    return h


def hierarchical_moe(x2, w_group, b_group, w_router, b_router, w_gate, w_up, w_down):
    n = x2.shape[0]
    g_prob = jax.nn.softmax((x2 @ w_group + b_group).astype(jnp.float32), axis=-1)
    g_top_p, g_idx = lax.top_k(g_prob, 1)
    e_logits = (x2 @ w_router + b_router).astype(jnp.float32).reshape(n, N_GROUPS, EXPERTS_PER_GROUP)
    e_in_group = jnp.take_along_axis(e_logits, g_idx[:, :, None], axis=1)[:, 0]
    e_top, e_idx = lax.top_k(e_in_group, TOP_K)
    weights = jax.nn.softmax(e_top, axis=-1) * g_top_p
    expert_ids = g_idx * EXPERTS_PER_GROUP + e_idx
    gates = jnp.einsum('nk,nke->ne', weights,
                       jax.nn.one_hot(expert_ids, N_EXPERTS, dtype=jnp.float32)).astype(x2.dtype)
    out = jnp.zeros_like(x2)
    for e in range(N_EXPERTS):
        hdn = jax.nn.silu(x2 @ w_gate[e]) * (x2 @ w_up[e])
        out = out + gates[:, e:e + 1] * (hdn @ w_down[e])
    return out


def setup_inputs(seed: int = 0) -> dict:
    key = jax.random.key(seed)
    ks = jax.random.split(key, 24)
    f32 = jnp.float32

    def nrm(k, shape, scale):
        return jax.random.normal(k, shape, f32) * scale

    a0 = jax.random.uniform(ks[12], (DEPTH, 2, LRU_WIDTH), f32, 0.9, 0.999)
    return {
        'x': nrm(ks[0], (BATCH, SEQ, D_MODEL), 1.0),
        'meta_tokens': nrm(ks[1], (N_META, D_MODEL), 1.0),
        'norm_mix_g': 1.0 + nrm(ks[2], (DEPTH, D_MODEL), 0.02),
        'w_in': nrm(ks[3], (DEPTH, D_MODEL, IN_WIDTH), D_MODEL ** -0.5),
        'conv_w': nrm(ks[4], (DEPTH, CONV_WIDTH, LRU_WIDTH), CONV_WIDTH ** -0.5),
        'conv_b': nrm(ks[5], (DEPTH, LRU_WIDTH), 0.01),
        'lru_w_a': nrm(ks[6], (DEPTH, 2, LRU_BLOCKS, LRU_BLOCK_DIM, LRU_BLOCK_DIM), LRU_BLOCK_DIM ** -0.5),
        'lru_b_a': nrm(ks[7], (DEPTH, 2, LRU_WIDTH), 0.01),
        'lru_w_x': nrm(ks[8], (DEPTH, 2, LRU_BLOCKS, LRU_BLOCK_DIM, LRU_BLOCK_DIM), LRU_BLOCK_DIM ** -0.5),
        'lru_b_x': nrm(ks[9], (DEPTH, 2, LRU_WIDTH), 0.01),
        'lru_lambda': jnp.log(a0) - jnp.log1p(-a0),
        'attn_sink': nrm(ks[10], (DEPTH, N_HEADS), 0.5),
        'w_attn_branch': nrm(ks[11], (DEPTH, ATTN_WIDTH, D_MODEL), ATTN_WIDTH ** -0.5),
        'w_rec_branch': nrm(ks[13], (DEPTH, LRU_WIDTH, D_MODEL), LRU_WIDTH ** -0.5),
        'w_out': nrm(ks[14], (DEPTH, D_MODEL, D_MODEL), D_MODEL ** -0.5),
        'norm_ffn_g': 1.0 + nrm(ks[15], (DEPTH, D_MODEL), 0.02),
        'w_group': nrm(ks[16], (DEPTH, D_MODEL, N_GROUPS), D_MODEL ** -0.5),
        'b_group': nrm(ks[17], (DEPTH, N_GROUPS), 0.01),
        'w_router': nrm(ks[18], (DEPTH, D_MODEL, N_EXPERTS), D_MODEL ** -0.5),
        'b_router': nrm(ks[19], (DEPTH, N_EXPERTS), 0.01),
        'moe_w_gate': nrm(ks[20], (DEPTH, N_EXPERTS, D_MODEL, EXPERT_FF), D_MODEL ** -0.5),
        'moe_w_up': nrm(ks[21], (DEPTH, N_EXPERTS, D_MODEL, EXPERT_FF), D_MODEL ** -0.5),
        'moe_w_down': nrm(ks[22], (DEPTH, N_EXPERTS, EXPERT_FF, D_MODEL), EXPERT_FF ** -0.5),
        'final_norm_g': 1.0 + nrm(ks[23], (D_MODEL,), 0.02),
    }


def reference(x, meta_tokens, norm_mix_g, w_in, conv_w, conv_b, lru_w_a, lru_b_a, lru_w_x, lru_b_x,
              lru_lambda, attn_sink, w_attn_branch, w_rec_branch, w_out, norm_ffn_g, w_group, b_group,
              w_router, b_router, moe_w_gate, moe_w_up, moe_w_down, final_norm_g):
    batch = x.shape[0]
    meta = jnp.broadcast_to(meta_tokens[None].astype(x.dtype), (batch, N_META, D_MODEL))
    h = jnp.concatenate([meta, x], axis=1)
    t_len = h.shape[1]
    for l in range(DEPTH):
        n = rms_norm(h, norm_mix_g[l])
        z = n @ w_in[l]
        q, k, v, xr, yr, gate_logits = jnp.split(z, IN_SPLITS, axis=-1)
        q = q.reshape(batch, t_len, N_HEADS, HEAD_DIM)
        k = k.reshape(batch, t_len, N_KV_HEADS, HEAD_DIM)
        v = v.reshape(batch, t_len, N_KV_HEADS, HEAD_DIM)
        attn = banded_window_attention(q, k, v, attn_sink[l]) @ w_attn_branch[l]
        xc = centred_depthwise_conv(xr, conv_w[l], conv_b[l])
        rec = (rg_lru(xc, lru_w_a[l, 0], lru_b_a[l, 0], lru_w_x[l, 0], lru_b_x[l, 0], lru_lambda[l, 0], False)
               + rg_lru(xc, lru_w_a[l, 1], lru_b_a[l, 1], lru_w_x[l, 1], lru_b_x[l, 1], lru_lambda[l, 1], True))
        rec = (rec.astype(x.dtype) * jax.nn.gelu(yr)) @ w_rec_branch[l]
        g_attn, g_rec = jnp.split(jax.nn.sigmoid(gate_logits), N_BRANCHES, axis=-1)
        h = h + (g_attn * attn + g_rec * rec) @ w_out[l]
        n2 = rms_norm(h, norm_ffn_g[l]).reshape(-1, D_MODEL)
        h = h + hierarchical_moe(n2, w_group[l], b_group[l], w_router[l], b_router[l],
                                 moe_w_gate[l], moe_w_up[l], moe_w_down[l]).reshape(h.shape)
    return rms_norm(h, final_norm_g)[:, N_META:]
```

```cpp
#include <hip/hip_runtime.h>
#include <cstdio>
#include <cstdint>

#define GAS __attribute__((address_space(1)))
#define LAS __attribute__((address_space(3)))
typedef unsigned short bf16;
typedef unsigned v4u __attribute__((ext_vector_type(4)));
typedef unsigned v2u __attribute__((ext_vector_type(2)));
typedef float f32x4 __attribute__((ext_vector_type(4)));
typedef short bf16x8 __attribute__((ext_vector_type(8)));
typedef GAS unsigned gu32;

constexpr int BATCH = 2, SEQ = 8192, D = 1024, NMETA = 16, TLEN = SEQ + NMETA;
constexpr int MREAL = BATCH * SEQ;
constexpr int MROWS = MREAL + NMETA;
constexpr int MPAD = 16640;
constexpr int NHEAD = 8, NKV = 2, HD = 128, KVW = NKV * HD;
constexpr int INW = 5632;
constexpr int C_Q = 0, C_K = 1024, C_V = 1280, C_XR = 1536, C_YR = 2560, C_GA = 3584, C_GR = 4608;
constexpr int NEXP = 16, NGRP = 4, EPG = 4, FF = 512;
constexpr float EPS = 1e-6f;
constexpr float LOG2E = 1.4426950408889634f;
constexpr float QSCALE = 0.08838834764831845f * LOG2E;

constexpr size_t MiB = 1u << 20;
constexpr size_t WS_CTL = 0, CTL_ZERO_BYTES = 1 * MiB;
constexpr size_t WS_WIN = 1 * MiB;
constexpr size_t WS_WATT = 12 * MiB, WS_WREC = 14 * MiB, WS_WOUT = 16 * MiB;
constexpr size_t WS_WLRU = 18 * MiB;
constexpr size_t WS_WGU = 19 * MiB;
constexpr size_t WS_WD = 51 * MiB;
constexpr size_t WS_Q = 67 * MiB;
constexpr size_t WS_K = 99 * MiB;
constexpr size_t WS_V = 107 * MiB + 512 * 1024;
constexpr size_t WS_XR = 116 * MiB;
constexpr size_t WS_GY = 148 * MiB + 512 * 1024;
constexpr size_t WS_GA = 180 * MiB + 512 * 1024;
constexpr size_t WS_GR = 212 * MiB + 512 * 1024;
constexpr size_t WS_LIST = 244 * MiB + 512 * 1024;
constexpr size_t WS_WLIST = 245 * MiB + 512 * 1024;
constexpr size_t WS_SUM = 246 * MiB + 512 * 1024;
constexpr size_t WS_END = 248 * MiB;
constexpr int CW_TMO = 0, CW_CODE = 1, CW_BAR = 4096, CW_CNT = 8192;

constexpr int RING_BYTES = 131072;
constexpr int LDSCTL_OFF = RING_BYTES, MISC_OFF = LDSCTL_OFF + 320;
constexpr int LDS_BYTES = 147456;
constexpr int NWAVES = 8, NTHREADS = 512;

#define RLX_AGENT __ATOMIC_RELAXED, __HIP_MEMORY_SCOPE_AGENT
#define LDS_WAIT() asm volatile("s_waitcnt lgkmcnt(0)" ::: "memory")
#define VM_WAIT() asm volatile("s_waitcnt vmcnt(0)" ::: "memory")

__device__ __forceinline__ unsigned f2bf(float f) { unsigned u = __builtin_bit_cast(unsigned, f); return (u + 0x7fffu + ((u >> 16) & 1u)) >> 16; }
__device__ __forceinline__ unsigned pk2(float lo, float hi) { return f2bf(lo) | (f2bf(hi) << 16); }
__device__ __forceinline__ float bf2f(unsigned short h) { return __builtin_bit_cast(float, (unsigned)h << 16); }
__device__ __forceinline__ float bflo(unsigned w) { return __builtin_bit_cast(float, w << 16); }
__device__ __forceinline__ float bfhi(unsigned w) { return __builtin_bit_cast(float, w & 0xffff0000u); }
__device__ __forceinline__ float wave_sum(float v) {
#pragma unroll
    for (int o = 1; o < 64; o <<= 1) v += __shfl_xor(v, o);
    return v;
}
__device__ __forceinline__ float wave_max(float v) {
#pragma unroll
    for (int o = 1; o < 64; o <<= 1) v = fmaxf(v, __shfl_xor(v, o));
    return v;
}
__device__ __forceinline__ float sigmoidf_(float x) { return 1.f / (1.f + __expf(-x)); }
__device__ __forceinline__ float gelu_tanh(float x) { const float u = 0.7978845608028654f * (x + 0.044715f * x * x * x); return x / (1.f + __expf(-2.f * u)); }

#define XB_TMO      128
#define XB_XCNT(j)  (256  + 64 * (j))
#define XB_XSUB(j)  (1280 + 64 * (j))
#define XB_XGEN(j)  (2304 + 64 * (j))
#define XB_TOP      3328
#define XB_TOPGEN   3392
#define XCD_BAR_WORDS 3456
#define XB_SPIN_CAP (1u << 24)
__device__ __forceinline__ unsigned xb_ld(unsigned* p)              { return __hip_atomic_load(p, __ATOMIC_RELAXED, __HIP_MEMORY_SCOPE_AGENT); }
__device__ __forceinline__ unsigned xb_add(unsigned* p, unsigned v) { return __hip_atomic_fetch_add(p, v, __ATOMIC_RELAXED, __HIP_MEMORY_SCOPE_AGENT); }
__device__ __forceinline__ unsigned xb_xcc_id() { return (unsigned)__builtin_amdgcn_s_getreg((3 << 11) | 20) & 0xFu; }
#define XB_SPIN(cond, bar) do { unsigned _sp = 0; while (cond) { __builtin_amdgcn_s_sleep(1); \
    if ((++_sp & 255u) == 0u) { if (xb_ld(&(bar)[XB_TMO])) break; if (_sp > XB_SPIN_CAP) { atomicAdd(&(bar)[XB_TMO], 1u); break; } } } } while (0)
struct XcdBarrier { unsigned* bar; unsigned x; volatile LAS unsigned* st; };
__device__ __forceinline__ XcdBarrier xcd_barrier_post(unsigned* bar, volatile LAS unsigned* st) {
    XcdBarrier b; b.bar = bar; b.x = xb_xcc_id(); b.st = st;
    if (threadIdx.x == 0) (void)xb_add(&bar[XB_XCNT(b.x)], 1u);
    return b;
}
__device__ __forceinline__ void xcd_barrier_complete(unsigned* bar, unsigned x, unsigned& nloc, unsigned& nx) {
    const unsigned G = gridDim.x * gridDim.y * gridDim.z;
    unsigned sum, cnt, mine, sp = 0u;
    for (;;) {
        sum = 0u; cnt = 0u; mine = 0u;
#pragma unroll
        for (unsigned j = 0; j < 16; ++j) { const unsigned c = xb_ld(&bar[XB_XCNT(j)]); sum += c; cnt += (c > 0u) ? 1u : 0u; mine = (j == x) ? c : mine; }
        if (sum == G) break;
        __builtin_amdgcn_s_sleep(1);
        if ((++sp & 255u) == 0u) { if (xb_ld(&bar[XB_TMO])) break; if (sp > XB_SPIN_CAP) { atomicAdd(&bar[XB_TMO], 1u); break; } }
    }
    nloc = mine > 0u ? mine : 1u; nx = cnt > 0u ? cnt : 1u;
}
__device__ __forceinline__ void xcd_barrier(const XcdBarrier& b) {
    asm volatile("s_waitcnt vmcnt(0)" ::: "memory");
    __syncthreads();
    if (threadIdx.x == 0) {
        unsigned* bar = b.bar;
        __builtin_amdgcn_s_waitcnt(0);
        unsigned nloc = b.st[0], nx = b.st[1];
        if (nloc == 0u) { xcd_barrier_complete(bar, b.x, nloc, nx); b.st[0] = nloc; b.st[1] = nx; }
        const unsigned old = xb_add(&bar[XB_XSUB(b.x)], 1u);
        const unsigned gen = old / nloc;
        if (old + 1u == (gen + 1u) * nloc) {
            __builtin_amdgcn_fence(__ATOMIC_RELEASE, "agent");
            asm volatile("s_waitcnt vmcnt(0)" ::: "memory");
            const unsigned og = xb_add(&bar[XB_TOP], 1u);
            const unsigned tg = og / nx;
            if (og + 1u == (tg + 1u) * nx) xb_add(&bar[XB_TOPGEN], 1u);
            else XB_SPIN(xb_ld(&bar[XB_TOPGEN]) == tg, bar);
            __builtin_amdgcn_fence(__ATOMIC_ACQUIRE, "agent");
            xb_add(&bar[XB_XGEN(b.x)], 1u);
            asm volatile("s_waitcnt vmcnt(0)" ::: "memory");
        } else {
            XB_SPIN(xb_ld(&bar[XB_XGEN(b.x)]) == gen, bar);
            __builtin_amdgcn_fence(__ATOMIC_ACQUIRE, "agent");
            asm volatile("s_waitcnt vmcnt(0)" ::: "memory");
        }
    }
    __syncthreads();
}

struct Args { const float* in[24]; float* out; unsigned char* ws; int ph_lo, ph_hi, use_bar, pad; };
struct Frame {
    LAS unsigned char* lds;
    volatile LAS unsigned* MISC;
    gu32* ctl;
    int tid, lane, wave, vcu, G;
    float* out; unsigned char* ws;
};
#define I_X 0
#define I_META 1
#define I_GMIX 2
#define I_WIN 3
#define I_CONVW 4
#define I_CONVB 5
#define I_LWA 6
#define I_LBA 7
#define I_LWX 8
#define I_LBX 9
#define I_LAM 10
#define I_SINK 11
#define I_WATT 12
#define I_WREC 13
#define I_WOUT 14
#define I_GFFN 15
#define I_WGRP 16
#define I_BGRP 17
#define I_WRT 18
#define I_BRT 19
#define I_MWG 20
#define I_MWU 21
#define I_MWD 22
#define I_GFIN 23

__device__ __forceinline__ void transpose_item(const float* W, int ldw, int k0, int n0, bf16* WT, int ldt, int drow0, int dk0, float scale, LAS float* scr, int lane) {
#pragma unroll 8
    for (int i = 0; i < 32; ++i) { const int kk = 2 * i + (lane >> 5); scr[kk * 33 + (lane & 31)] = W[(size_t)(k0 + kk) * ldw + n0 + (lane & 31)] * scale; }
    LDS_WAIT(); asm volatile("" ::: "memory");
    const int c = lane & 7;
#pragma unroll
    for (int j = 0; j < 4; ++j) { const int n = (lane >> 3) + 8 * j; const LAS float* s = scr + (8 * c) * 33 + n;
        v4u o; o.x = pk2(s[0 * 33], s[1 * 33]); o.y = pk2(s[2 * 33], s[3 * 33]); o.z = pk2(s[4 * 33], s[5 * 33]); o.w = pk2(s[6 * 33], s[7 * 33]);
        *(GAS v4u*)(WT + (size_t)(drow0 + n) * ldt + dk0 + 8 * c) = o; }
    LDS_WAIT(); asm volatile("" ::: "memory");
}
__device__ __forceinline__ void p0_prologue(Frame& F, const Args& A) {
    LAS float* scr = (LAS float*)(F.lds + F.wave * 16384);
    const int gw = F.vcu * NWAVES + F.wave, NGW = F.G * NWAVES, lane = F.lane;
    unsigned char* ws = F.ws;
    constexpr int I_IN = 16 * 176, I_SQ = 16 * 32, I_LRU = 32 * 8, I_MG = 16 * 16, I_MD = 8 * 32;
    constexpr int NITEMS = I_IN + 3 * I_SQ + I_LRU + NEXP * (2 * I_MG + I_MD);
    for (int it = gw; it < NITEMS; it += NGW) {
        int r = it;
        if (r < I_IN) { const int kb = r / 176, nb = r % 176; transpose_item(A.in[I_WIN], INW, 64 * kb, 32 * nb, (bf16*)(ws + WS_WIN), D, 32 * nb, 64 * kb, 1.f, scr, lane); continue; } r -= I_IN;
        if (r < 3 * I_SQ) { const int w = r / I_SQ, q = r % I_SQ, kb = q / 32, nb = q % 32;
            const float* W = w == 0 ? A.in[I_WATT] : (w == 1 ? A.in[I_WREC] : A.in[I_WOUT]); bf16* WT = (bf16*)(ws + (w == 0 ? WS_WATT : (w == 1 ? WS_WREC : WS_WOUT)));
            transpose_item(W, D, 64 * kb, 32 * nb, WT, D, 32 * nb, 64 * kb, 1.f, scr, lane); continue; } r -= 3 * I_SQ;
        if (r < I_LRU) { const int mat = r / 8, q = r % 8, kb = q / 4, nb = q % 4; const int dir = mat >> 4, gate = (mat >> 3) & 1, n = mat & 7;
            const float* W = (gate ? A.in[I_LWX] : A.in[I_LWA]) + (size_t)(dir * 8 + n) * 128 * 128;
            transpose_item(W, 128, 64 * kb, 32 * nb, (bf16*)(ws + WS_WLRU) + (size_t)n * 512 * 128, 128, (dir * 2 + gate) * 128 + 32 * nb, 64 * kb, -LOG2E, scr, lane); continue; } r -= I_LRU;
        { const int e = r / (2 * I_MG + I_MD); int q = r % (2 * I_MG + I_MD);
          if (q < 2 * I_MG) { const int up = q / I_MG; q %= I_MG; const int kb = q / 16, nb = q % 16; const int n0 = 32 * nb;
              const float* W = (up ? A.in[I_MWU] : A.in[I_MWG]) + (size_t)e * D * FF;
              transpose_item(W, FF, 64 * kb, n0, (bf16*)(ws + WS_WGU) + (size_t)e * 1024 * 1024, D, (n0 >> 7) * 256 + (n0 & 127) + up * 128, 64 * kb, 1.f, scr, lane); }
          else { q -= 2 * I_MG; const int kb = q / 32, nb = q % 32;
              transpose_item(A.in[I_MWD] + (size_t)e * FF * D, D, 64 * kb, 32 * nb, (bf16*)(ws + WS_WD) + (size_t)e * 1024 * 512, FF, 32 * nb, 64 * kb, 1.f, scr, lane); } }
    }
    bf16* XN = (bf16*)F.out;
    const GAS f32x4* g4 = (const GAS f32x4*)A.in[I_GMIX] + lane;
    for (int m = gw; m < MPAD; m += NGW) {
        GAS v2u* o8 = (GAS v2u*)(XN + (size_t)m * D) + lane;
        if (m >= MROWS) {
#pragma unroll
            for (int j = 0; j < 4; ++j) o8[64 * j] = (v2u){0u, 0u};
            continue; }
        const float* xrow = m < MREAL ? A.in[I_X] + (size_t)m * D : A.in[I_META] + (size_t)(m - MREAL) * D;
        const GAS f32x4* xr = (const GAS f32x4*)xrow + lane;
        f32x4 v[4]; float s = 0.f;
#pragma unroll
        for (int j = 0; j < 4; ++j) { v[j] = xr[64 * j]; s += (v[j].x * v[j].x + v[j].y * v[j].y) + (v[j].z * v[j].z + v[j].w * v[j].w); }
        const float rstd = 1.f / sqrtf(wave_sum(s) * (1.f / D) + EPS);
#pragma unroll
        for (int j = 0; j < 4; ++j) { const f32x4 g = g4[64 * j]; o8[64 * j] = (v2u){pk2(v[j].x * rstd * g.x, v[j].y * rstd * g.y), pk2(v[j].z * rstd * g.z, v[j].w * rstd * g.w)}; }
    }
}

__device__ __forceinline__ void wave_gemm32(const bf16* a0, const bf16* a1, const bf16* b0, const bf16* b1, int K, f32x4 (&acc)[2][2]) {
    for (int k0 = 0; k0 < K; k0 += 32) {
        const bf16x8 A0 = *(const bf16x8*)(a0 + k0), A1 = *(const bf16x8*)(a1 + k0), B0 = *(const bf16x8*)(b0 + k0), B1 = *(const bf16x8*)(b1 + k0);
        acc[0][0] = __builtin_amdgcn_mfma_f32_16x16x32_bf16(A0, B0, acc[0][0], 0, 0, 0);
        acc[0][1] = __builtin_amdgcn_mfma_f32_16x16x32_bf16(A0, B1, acc[0][1], 0, 0, 0);
        acc[1][0] = __builtin_amdgcn_mfma_f32_16x16x32_bf16(A1, B0, acc[1][0], 0, 0, 0);
        acc[1][1] = __builtin_amdgcn_mfma_f32_16x16x32_bf16(A1, B1, acc[1][1], 0, 0, 0);
    }
}
#define ZERO_ACC(acc) do { _Pragma("unroll") for (int _i = 0; _i < 2; ++_i) _Pragma("unroll") for (int _j = 0; _j < 2; ++_j) acc[_i][_j] = (f32x4){0.f, 0.f, 0.f, 0.f}; } while (0)

__device__ __forceinline__ void p1_store(unsigned char* ws, int row, int col, float v) {
    if (col < C_K) { if (row < MREAL) ((bf16*)(ws + WS_Q))[(size_t)row * D + col] = (bf16)f2bf(v * QSCALE); }
    else if (col < C_V) ((bf16*)(ws + WS_K))[(size_t)row * KVW + (col - C_K)] = (bf16)f2bf(v);
    else if (col < C_XR) ((bf16*)(ws + WS_V))[(size_t)row * KVW + (col - C_V)] = (bf16)f2bf(v);
    else if (col < C_YR) ((bf16*)(ws + WS_XR))[(size_t)row * D + (col - C_XR)] = (bf16)f2bf(v);
    else if (col < C_GA) { if (row < MREAL) ((bf16*)(ws + WS_GY))[(size_t)row * D + (col - C_YR)] = (bf16)f2bf(gelu_tanh(v)); }
    else if (col < C_GR) { if (row < MREAL) ((bf16*)(ws + WS_GA))[(size_t)row * D + (col - C_GA)] = (bf16)f2bf(sigmoidf_(v)); }
    else { if (row < MREAL) ((bf16*)(ws + WS_GR))[(size_t)row * D + (col - C_GR)] = (bf16)f2bf(sigmoidf_(v)); }
}
__device__ __forceinline__ void p1_simple(Frame& F, const Args& A) {
    const int gw = F.vcu * NWAVES + F.wave, NGW = F.G * NWAVES, lane = F.lane, fr = lane & 15, fq = lane >> 4;
    const bf16* XN = (const bf16*)F.out; const bf16* WT = (const bf16*)(F.ws + WS_WIN);
    constexpr int NTM = 513, NTN = INW / 32;
    for (int it = gw; it < NTM * NTN; it += NGW) {
        const int tm = it / NTN, tn = it % NTN, m0 = tm * 32, n0 = tn * 32;
        f32x4 acc[2][2]; ZERO_ACC(acc);
        wave_gemm32(XN + (size_t)(m0 + fr) * D + 8 * fq, XN + (size_t)(m0 + 16 + fr) * D + 8 * fq, WT + (size_t)(n0 + fr) * D + 8 * fq, WT + (size_t)(n0 + 16 + fr) * D + 8 * fq, D, acc);
#pragma unroll
        for (int i = 0; i < 2; ++i)
#pragma unroll
            for (int j = 0; j < 2; ++j)
#pragma unroll
                for (int r = 0; r < 4; ++r) p1_store(F.ws, m0 + 16 * i + 4 * fq + r, n0 + 16 * j + fr, acc[i][j][r]);
    }
}

__device__ __forceinline__ void attn_simple(Frame& F, const Args& A) {
    const int gw = F.vcu * NWAVES + F.wave, NGW = F.G * NWAVES, lane = F.lane;
    bf16* Q = (bf16*)(F.ws + WS_Q); const bf16* Kb = (const bf16*)(F.ws + WS_K); const bf16* Vb = (const bf16*)(F.ws + WS_V);
    LAS float* sc = (LAS float*)(F.lds + F.wave * 2048);
    for (int it = gw; it < MREAL * NHEAD; it += NGW) {
        const int r = it >> 3, h = it & 7, b = r / SEQ, s = r % SEQ, kv = h >> 2;
        const float slope2 = exp2f(-(float)(h + 1)) * LOG2E;
        const float sink2 = A.in[I_SINK][h] * LOG2E;
        const unsigned qw = *(const unsigned*)(Q + (size_t)r * D + h * HD + 2 * lane);
        const float q0 = bflo(qw), q1 = bfhi(qw);
        const int s_lo = s - 128 < 0 ? 0 : s - 128, s_hi = s + 128 > SEQ - 1 ? SEQ - 1 : s + 128, nb = s_hi - s_lo + 1, tot = nb + NMETA;
        for (int j = 0; j < tot; ++j) {
            const int krow = j < nb ? b * SEQ + s_lo + j : MREAL + (j - nb);
            const unsigned kw = *(const unsigned*)(Kb + (size_t)krow * KVW + kv * HD + 2 * lane);
            float d = wave_sum(q0 * bflo(kw) + q1 * bfhi(kw));
            if (j < nb) { const int dd = s_lo + j - s; d -= slope2 * (float)(dd < 0 ? -dd : dd); }
            if (lane == 0) sc[j] = d;
        }
        LDS_WAIT(); asm volatile("" ::: "memory");
        float mx = sink2;
        for (int j = lane; j < tot; j += 64) mx = fmaxf(mx, sc[j]);
        mx = wave_max(mx);
        float ls = 0.f;
        for (int j = lane; j < tot; j += 64) { const float p = exp2f(sc[j] - mx); sc[j] = p; ls += p; }
        ls = wave_sum(ls) + exp2f(sink2 - mx);
        LDS_WAIT(); asm volatile("" ::: "memory");
        float o0 = 0.f, o1 = 0.f;
        for (int j = 0; j < tot; ++j) {
            const int krow = j < nb ? b * SEQ + s_lo + j : MREAL + (j - nb);
            const unsigned vw = *(const unsigned*)(Vb + (size_t)krow * KVW + kv * HD + 2 * lane);
            const float p = sc[j]; o0 += p * bflo(vw); o1 += p * bfhi(vw);
        }
        const float il = 1.f / ls;
        *(unsigned*)(Q + (size_t)r * D + h * HD + 2 * lane) = pk2(o0 * il, o1 * il);
        LDS_WAIT(); asm volatile("" ::: "memory");
    }
}

__device__ __forceinline__ int trow(int b, int t) { return t < NMETA ? MREAL + t : b * SEQ + (t - NMETA); }
__device__ __forceinline__ void scan_simple(Frame& F, const Args& A) {
    if (F.vcu >= 16) return;
    const int b = F.vcu >> 3, n = F.vcu & 7, tid = F.tid;
    const int e = tid & 127, gate = (tid >> 7) & 1, kh = tid >> 8;
    LAS float* xcs = (LAS float*)F.lds;
    LAS float* pp = (LAS float*)(F.lds + 8192);
    const bf16* XR = (const bf16*)(F.ws + WS_XR); bf16* GY = (bf16*)(F.ws + WS_GY); float* HF = F.out;
    const float* cw = A.in[I_CONVW]; const float* cb = A.in[I_CONVB];
    for (int dir = 0; dir < 2; ++dir) {
        float w[64];
        { const float* W = (gate ? A.in[I_LWX] : A.in[I_LWA]) + (size_t)(dir * 8 + n) * 128 * 128 + (size_t)(64 * kh) * 128 + e;
#pragma unroll
          for (int dd = 0; dd < 64; ++dd) w[dd] = W[dd * 128]; }
        const int ch = 128 * n + e;
        const float ba = A.in[I_LBA][dir * D + ch], bx = A.in[I_LBX][dir * D + ch], lam = A.in[I_LAM][dir * D + ch];
        const float sp8 = 8.f * log1pf(__expf(-lam));
        float h = 0.f;
        for (int ci = 0; ci < TLEN / 16; ++ci) {
            const int c = dir ? (TLEN / 16 - 1 - ci) : ci, t0 = 16 * c;
            for (int idx = tid; idx < 2048; idx += NTHREADS) { const int tt = idx >> 7, cc = idx & 127, t = t0 + tt, gc = 128 * n + cc;
                float a = cb[gc];
#pragma unroll
                for (int j = 0; j < 4; ++j) { const int ts = t - 2 + j; if (ts >= 0 && ts < TLEN) a += cw[j * D + gc] * bf2f(XR[(size_t)trow(b, ts) * D + gc]); }
                xcs[idx] = a; }
            __syncthreads();
            for (int tt = 0; tt < 16; ++tt) { float p = 0.f; const LAS float* xs = xcs + tt * 128 + 64 * kh;
#pragma unroll
                for (int dd = 0; dd < 64; ++dd) p += w[dd] * xs[dd];
                pp[((kh * 2 + gate) * 16 + tt) * 128 + e] = p; }
            __syncthreads();
            if (tid < 128) {
                for (int k = 0; k < 16; ++k) { const int tt = dir ? 15 - k : k, t = t0 + tt;
                    const float pa = pp[((0 * 2 + 0) * 16 + tt) * 128 + e] + pp[((1 * 2 + 0) * 16 + tt) * 128 + e] + ba;
                    const float px = pp[((0 * 2 + 1) * 16 + tt) * 128 + e] + pp[((1 * 2 + 1) * 16 + tt) * 128 + e] + bx;
                    const float rg = sigmoidf_(pa), ig = sigmoidf_(px);
                    const float la = -sp8 * rg, a = __expf(la), u = sqrtf(-expm1f(2.f * la)) * (ig * xcs[tt * 128 + e]);
                    h = a * h + u;
                    if (t >= NMETA) { const size_t off = (size_t)(b * SEQ + t - NMETA) * D + ch;
                        if (dir == 0) HF[off] = h;
                        else GY[off] = (bf16)f2bf((HF[off] + h) * bf2f(GY[off])); } }
            }
            __syncthreads();
        }
        VM_WAIT(); __syncthreads();
    }
}

__device__ __forceinline__ void merge_simple(Frame& F, const Args& A) {
    const int gw = F.vcu * NWAVES + F.wave, NGW = F.G * NWAVES, lane = F.lane, fr = lane & 15, fq = lane >> 4;
    const bf16* AO = (const bf16*)(F.ws + WS_Q); const bf16* REC = (const bf16*)(F.ws + WS_GY);
    const bf16* WA = (const bf16*)(F.ws + WS_WATT); const bf16* WR = (const bf16*)(F.ws + WS_WREC);
    const bf16* GA = (const bf16*)(F.ws + WS_GA); const bf16* GR = (const bf16*)(F.ws + WS_GR); bf16* M = (bf16*)(F.ws + WS_XR);
    for (int it = gw; it < 512 * 32; it += NGW) {
        const int m0 = (it >> 5) * 32, n0 = (it & 31) * 32;
        f32x4 a1[2][2], a2[2][2]; ZERO_ACC(a1); ZERO_ACC(a2);
        wave_gemm32(AO + (size_t)(m0 + fr) * D + 8 * fq, AO + (size_t)(m0 + 16 + fr) * D + 8 * fq, WA + (size_t)(n0 + fr) * D + 8 * fq, WA + (size_t)(n0 + 16 + fr) * D + 8 * fq, D, a1);
        wave_gemm32(REC + (size_t)(m0 + fr) * D + 8 * fq, REC + (size_t)(m0 + 16 + fr) * D + 8 * fq, WR + (size_t)(n0 + fr) * D + 8 * fq, WR + (size_t)(n0 + 16 + fr) * D + 8 * fq, D, a2);
#pragma unroll
        for (int i = 0; i < 2; ++i)
#pragma unroll
            for (int j = 0; j < 2; ++j)
#pragma unroll
                for (int r = 0; r < 4; ++r) { const size_t off = (size_t)(m0 + 16 * i + 4 * fq + r) * D + n0 + 16 * j + fr;
                    M[off] = (bf16)f2bf(bf2f(GA[off]) * a1[i][j][r] + bf2f(GR[off]) * a2[i][j][r]); }
    }
}
__device__ __forceinline__ void wout_simple(Frame& F, const Args& A) {
    const int gw = F.vcu * NWAVES + F.wave, NGW = F.G * NWAVES, lane = F.lane, fr = lane & 15, fq = lane >> 4;
    const bf16* M = (const bf16*)(F.ws + WS_XR); const bf16* WO = (const bf16*)(F.ws + WS_WOUT);
    for (int it = gw; it < 512 * 32; it += NGW) {
        const int m0 = (it >> 5) * 32, n0 = (it & 31) * 32;
        f32x4 acc[2][2]; ZERO_ACC(acc);
        wave_gemm32(M + (size_t)(m0 + fr) * D + 8 * fq, M + (size_t)(m0 + 16 + fr) * D + 8 * fq, WO + (size_t)(n0 + fr) * D + 8 * fq, WO + (size_t)(n0 + 16 + fr) * D + 8 * fq, D, acc);
#pragma unroll
        for (int i = 0; i < 2; ++i)
#pragma unroll
            for (int j = 0; j < 2; ++j)
#pragma unroll
                for (int r = 0; r < 4; ++r) { const size_t off = (size_t)(m0 + 16 * i + 4 * fq + r) * D + n0 + 16 * j + fr; F.out[off] = A.in[I_X][off] + acc[i][j][r]; }
    }
}
__device__ __forceinline__ void route_simple(Frame& F, const Args& A) {
    const int gw = F.vcu * NWAVES + F.wave, NGW = F.G * NWAVES, lane = F.lane;
    bf16* N2 = (bf16*)(F.ws + WS_Q);
    unsigned* LIST = (unsigned*)(F.ws + WS_LIST); float* WLIST = (float*)(F.ws + WS_WLIST);
    const GAS f32x4* g4 = (const GAS f32x4*)A.in[I_GFFN] + lane;
    const f32x4* wg4 = (const f32x4*)A.in[I_WGRP]; const f32x4* wr4 = (const f32x4*)A.in[I_WRT];
    for (int m = gw; m < MREAL; m += NGW) {
        const GAS f32x4* hr = (const GAS f32x4*)(F.out + (size_t)m * D) + lane;
        f32x4 v[4]; float s = 0.f;
#pragma unroll
        for (int j = 0; j < 4; ++j) { v[j] = hr[64 * j]; s += (v[j].x * v[j].x + v[j].y * v[j].y) + (v[j].z * v[j].z + v[j].w * v[j].w); }
        const float rstd = 1.f / sqrtf(wave_sum(s) * (1.f / D) + EPS);
        GAS v2u* o8 = (GAS v2u*)(N2 + (size_t)m * D) + lane;
        float lg[20];
#pragma unroll
        for (int o = 0; o < 20; ++o) lg[o] = 0.f;
#pragma unroll
        for (int j = 0; j < 4; ++j) { const f32x4 g = g4[64 * j]; v[j].x *= rstd * g.x; v[j].y *= rstd * g.y; v[j].z *= rstd * g.z; v[j].w *= rstd * g.w;
            o8[64 * j] = (v2u){pk2(v[j].x, v[j].y), pk2(v[j].z, v[j].w)};
#pragma unroll
            for (int i = 0; i < 4; ++i) { const int col = 256 * j + 4 * lane + i; const float x = v[j][i];
                const f32x4 a = wg4[col]; lg[0] += x * a.x; lg[1] += x * a.y; lg[2] += x * a.z; lg[3] += x * a.w;
#pragma unroll
                for (int q = 0; q < 4; ++q) { const f32x4 c = wr4[col * 4 + q]; lg[4 + 4 * q] += x * c.x; lg[5 + 4 * q] += x * c.y; lg[6 + 4 * q] += x * c.z; lg[7 + 4 * q] += x * c.w; } } }
#pragma unroll
        for (int o = 0; o < 20; ++o) lg[o] = wave_sum(lg[o]);
        if (lane == 0) {
            float gl[4]; int gi = 0;
#pragma unroll
            for (int o = 0; o < 4; ++o) gl[o] = lg[o] + A.in[I_BGRP][o];
            float gm = gl[0];
#pragma unroll
            for (int o = 1; o < 4; ++o) if (gl[o] > gm) { gm = gl[o]; gi = o; }
            float gs = 0.f;
#pragma unroll
            for (int o = 0; o < 4; ++o) gs += __expf(gl[o] - gm);
            const float gp = 1.f / gs;
            float el[4];
#pragma unroll
            for (int o = 0; o < 4; ++o) { float x = 0.f;
#pragma unroll
                for (int g = 0; g < 4; ++g) x = (g == gi) ? lg[4 + 4 * g + o] + A.in[I_BRT][4 * g + o] : x;
                el[o] = x; }
            int i1 = 0; float e1 = el[0];
#pragma unroll
            for (int o = 1; o < 4; ++o) if (el[o] > e1) { e1 = el[o]; i1 = o; }
            int i2 = -1; float e2 = -3.0e38f;
#pragma unroll
            for (int o = 0; o < 4; ++o) if (o != i1 && el[o] > e2) { e2 = el[o]; i2 = o; }
            const float w1 = gp / (1.f + __expf(e2 - e1)), w2 = gp - w1;
            const int x1 = gi * EPG + i1, x2 = gi * EPG + i2;
            const unsigned p1 = atomicAdd((unsigned*)(F.ctl + CW_CNT + 64 * x1), 1u), p2 = atomicAdd((unsigned*)(F.ctl + CW_CNT + 64 * x2), 1u);
            LIST[x1 * MREAL + p1] = (unsigned)m; WLIST[x1 * MREAL + p1] = w1;
            LIST[x2 * MREAL + p2] = (unsigned)m | (1u << 14); WLIST[x2 * MREAL + p2] = w2;
        }
    }
}
struct ExpMap { int cnt[NEXP]; int off[NEXP]; };
__device__ __forceinline__ void moe1_simple(Frame& F, const Args& A) {
    const int gw = F.vcu * NWAVES + F.wave, NGW = F.G * NWAVES, lane = F.lane, fr = lane & 15, fq = lane >> 4;
    const bf16* N2 = (const bf16*)(F.ws + WS_Q); const unsigned* LIST = (const unsigned*)(F.ws + WS_LIST); bf16* HDN = (bf16*)(F.ws + WS_XR);
    int base = 0, off = 0;
    for (int e = 0; e < NEXP; ++e) {
        const int cnt = (int)__hip_atomic_load(F.ctl + CW_CNT + 64 * e, RLX_AGENT);
        const int ntm = (cnt + 31) >> 5, nit = ntm * 16;
        const bf16* WG = (const bf16*)(F.ws + WS_WGU) + (size_t)e * 1024 * 1024;
        int first = gw - (base % NGW); if (first < 0) first += NGW;
        for (int q = first; q < nit; q += NGW) {
            const int tm = q >> 4, tn = q & 15, j0 = 32 * tn;
            int i0 = tm * 32 + fr, i1 = i0 + 16; if (i0 >= cnt) i0 = 0; if (i1 >= cnt) i1 = 0;
            const int t0 = LIST[e * MREAL + i0] & 0x3fff, t1 = LIST[e * MREAL + i1] & 0x3fff;
            const int br = (j0 >> 7) * 256 + (j0 & 127);
            f32x4 ag[2][2], au[2][2]; ZERO_ACC(ag); ZERO_ACC(au);
            wave_gemm32(N2 + (size_t)t0 * D + 8 * fq, N2 + (size_t)t1 * D + 8 * fq, WG + (size_t)(br + fr) * D + 8 * fq, WG + (size_t)(br + 16 + fr) * D + 8 * fq, D, ag);
            wave_gemm32(N2 + (size_t)t0 * D + 8 * fq, N2 + (size_t)t1 * D + 8 * fq, WG + (size_t)(br + 128 + fr) * D + 8 * fq, WG + (size_t)(br + 144 + fr) * D + 8 * fq, D, au);
#pragma unroll
            for (int i = 0; i < 2; ++i)
#pragma unroll
                for (int j = 0; j < 2; ++j)
#pragma unroll
                    for (int r = 0; r < 4; ++r) { const int ii = tm * 32 + 16 * i + 4 * fq + r; const float g = ag[i][j][r], u = au[i][j][r];
                        HDN[(size_t)(off + ii) * FF + j0 + 16 * j + fr] = (bf16)f2bf(g / (1.f + __expf(-g)) * u); }
        }
        base += nit; off += (cnt + 255) & ~255;
    }
}
__device__ __forceinline__ void moe2_simple(Frame& F, const Args& A) {
    const int gw = F.vcu * NWAVES + F.wave, NGW = F.G * NWAVES, lane = F.lane, fr = lane & 15, fq = lane >> 4;
    const unsigned* LIST = (const unsigned*)(F.ws + WS_LIST); const float* WLIST = (const float*)(F.ws + WS_WLIST);
    const bf16* HDN = (const bf16*)(F.ws + WS_XR); bf16* Y = (bf16*)(F.ws + WS_GA);
    int base = 0, off = 0;
    for (int e = 0; e < NEXP; ++e) {
        const int cnt = (int)__hip_atomic_load(F.ctl + CW_CNT + 64 * e, RLX_AGENT);
        const int ntm = (cnt + 31) >> 5, nit = ntm * 32;
        const bf16* WD = (const bf16*)(F.ws + WS_WD) + (size_t)e * 1024 * 512;
        int first = gw - (base % NGW); if (first < 0) first += NGW;
        for (int q = first; q < nit; q += NGW) {
            const int tm = q >> 5, tn = q & 31, n0 = 32 * tn;
            f32x4 acc[2][2]; ZERO_ACC(acc);
            const bf16* a0 = HDN + (size_t)(off + tm * 32 + fr) * FF + 8 * fq;
            wave_gemm32(a0, a0 + 16 * FF, WD + (size_t)(n0 + fr) * FF + 8 * fq, WD + (size_t)(n0 + 16 + fr) * FF + 8 * fq, FF, acc);
#pragma unroll
            for (int i = 0; i < 2; ++i)
#pragma unroll
                for (int r = 0; r < 4; ++r) { const int ii = tm * 32 + 16 * i + 4 * fq + r;
                    if (ii < cnt) { const unsigned le = LIST[e * MREAL + ii]; const float w = WLIST[e * MREAL + ii]; const size_t row = (size_t)(le >> 14) * MREAL + (le & 0x3fff);
#pragma unroll
                        for (int j = 0; j < 2; ++j) Y[row * D + n0 + 16 * j + fr] = (bf16)f2bf(w * acc[i][j][r]); } }
        }
        base += nit; off += (cnt + 255) & ~255;
    }
}
__device__ __forceinline__ void final_rows(Frame& F, const Args& A) {
    const int gw = F.vcu * NWAVES + F.wave, NGW = F.G * NWAVES, lane = F.lane;
    const bf16* Y = (const bf16*)(F.ws + WS_GA);
    const GAS f32x4* g4 = (const GAS f32x4*)A.in[I_GFIN] + lane;
    for (int m = gw; m < MREAL; m += NGW) {
        GAS f32x4* hr = (GAS f32x4*)(F.out + (size_t)m * D) + lane;
        const GAS v2u* y0 = (const GAS v2u*)(Y + (size_t)m * D) + lane; const GAS v2u* y1 = (const GAS v2u*)(Y + (size_t)(MREAL + m) * D) + lane;
        f32x4 v[4]; float s = 0.f;
#pragma unroll
        for (int j = 0; j < 4; ++j) { v[j] = hr[64 * j]; const v2u a = y0[64 * j], c = y1[64 * j];
            v[j].x += bflo(a.x) + bflo(c.x); v[j].y += bfhi(a.x) + bfhi(c.x); v[j].z += bflo(a.y) + bflo(c.y); v[j].w += bfhi(a.y) + bfhi(c.y);
            s += (v[j].x * v[j].x + v[j].y * v[j].y) + (v[j].z * v[j].z + v[j].w * v[j].w); }
        const float rstd = 1.f / sqrtf(wave_sum(s) * (1.f / D) + EPS);
#pragma unroll
        for (int j = 0; j < 4; ++j) { const f32x4 g = g4[64 * j]; hr[64 * j] = (f32x4){v[j].x * rstd * g.x, v[j].y * rstd * g.y, v[j].z * rstd * g.z, v[j].w * rstd * g.w}; }
    }
}

constexpr int NPHASE = 9;
__global__ void __launch_bounds__(NTHREADS, 2) mega_fwd(Args args) {
    extern __shared__ __attribute__((aligned(16))) unsigned char lds[];
    Frame F;
    F.lds = (LAS unsigned char*)lds;
    F.MISC = (volatile LAS unsigned*)(F.lds + MISC_OFF);
    F.tid = threadIdx.x; F.lane = F.tid & 63; F.wave = __builtin_amdgcn_readfirstlane(F.tid >> 6);
    F.G = gridDim.x; { const int bx = blockIdx.x; F.vcu = (F.G % 8 == 0) ? (bx % 8) * (F.G / 8) + bx / 8 : bx; }
    F.ws = args.ws; F.out = args.out; F.ctl = (gu32*)(args.ws + WS_CTL);
    for (int u = F.tid; u < (LDS_BYTES - LDSCTL_OFF) / 4; u += NTHREADS) ((LAS unsigned*)(F.lds + LDSCTL_OFF))[u] = 0u;
    __syncthreads();
    XcdBarrier bar; bar.bar = (unsigned*)(F.ctl + CW_BAR); bar.x = 0; bar.st = nullptr;
    if (args.use_bar) bar = xcd_barrier_post((unsigned*)(F.ctl + CW_BAR), F.MISC + 8);
    const int lo = args.ph_lo, hi = args.ph_hi;
#define IN(k) (lo <= (k) && (k) < hi)
#define SEAM(k) do { if (IN(k) && IN((k) + 1)) xcd_barrier(bar); } while (0)
    if (IN(0)) { p0_prologue(F, args); } SEAM(0);
    if (IN(1)) { p1_simple(F, args); } SEAM(1);
    if (IN(2)) { scan_simple(F, args); attn_simple(F, args); } SEAM(2);
    if (IN(3)) { merge_simple(F, args); } SEAM(3);
    if (IN(4)) { wout_simple(F, args); } SEAM(4);
    if (IN(5)) { route_simple(F, args); } SEAM(5);
    if (IN(6)) { moe1_simple(F, args); } SEAM(6);
    if (IN(7)) { moe2_simple(F, args); } SEAM(7);
    if (IN(8)) { final_rows(F, args); }
#undef IN
#undef SEAM
}

#ifndef MK_N_LAUNCHES
#define MK_N_LAUNCHES 1
#endif
extern "C" void kernel_launch(void* const* d_in, const int* in_sizes, int n_in, void* d_out, int out_size, void* d_ws, size_t ws_size, hipStream_t stream) {
    static int grid = 0;
    if (grid == 0) {
        if (n_in != 24 || in_sizes[0] != MREAL * D || out_size != MREAL * D || ws_size < WS_END) {
            fprintf(stderr, "kernel_launch: unexpected shapes: n_in %d in0 %d out %d ws %zu (need %zu)\n", n_in, n_in > 0 ? in_sizes[0] : -1, out_size, ws_size, (size_t)WS_END); grid = -1; return; }
        int dev = 0, cus = 0, per_cu = 0;
        if (hipGetDevice(&dev) != hipSuccess || hipDeviceGetAttribute(&cus, hipDeviceAttributeMultiprocessorCount, dev) != hipSuccess) { grid = -1; return; }
        if (hipFuncSetAttribute((const void*)mega_fwd, hipFuncAttributeMaxDynamicSharedMemorySize, LDS_BYTES) != hipSuccess) { fprintf(stderr, "kernel_launch: hipFuncSetAttribute failed\n"); grid = -1; return; }
        if (hipOccupancyMaxActiveBlocksPerMultiprocessor(&per_cu, (const void*)mega_fwd, NTHREADS, LDS_BYTES) != hipSuccess || per_cu < 1) {
            fprintf(stderr, "kernel_launch: occupancy query says %d blocks per CU\n", per_cu); (void)hipGetLastError(); }
        grid = cus;
    }
    if (grid < 0) return;
    (void)hipMemsetAsync((char*)d_ws + WS_CTL, 0, CTL_ZERO_BYTES, stream);
    Args a{};
    for (int i = 0; i < 24; ++i) a.in[i] = (const float*)d_in[i];
    a.out = (float*)d_out; a.ws = (unsigned char*)d_ws;
    if (MK_N_LAUNCHES == 1) { a.ph_lo = 0; a.ph_hi = NPHASE; a.use_bar = 1; hipLaunchKernelGGL(mega_fwd, dim3(grid), dim3(NTHREADS), LDS_BYTES, stream, a); }
    else for (int p = 0; p < NPHASE; ++p) { a.ph_lo = p; a.ph_hi = p + 1; a.use_bar = 0; hipLaunchKernelGGL(mega_fwd, dim3(grid), dim3(NTHREADS), LDS_BYTES, stream, a); }
}
```

```cpp
#include <hip/hip_runtime.h>
#include <cstdio>
#include <cstdint>

#define GAS __attribute__((address_space(1)))
#define LAS __attribute__((address_space(3)))
typedef unsigned short bf16;
typedef unsigned v4u __attribute__((ext_vector_type(4)));
typedef unsigned v2u __attribute__((ext_vector_type(2)));
typedef float f32x4 __attribute__((ext_vector_type(4)));
typedef short bf16x8 __attribute__((ext_vector_type(8)));
typedef GAS unsigned gu32;

constexpr int BATCH = 2, SEQ = 8192, D = 1024, NMETA = 16, TLEN = SEQ + NMETA;
constexpr int MREAL = BATCH * SEQ;
constexpr int MROWS = MREAL + NMETA;
constexpr int MPAD = 16640;
constexpr int NHEAD = 8, NKV = 2, HD = 128, KVW = NKV * HD;
constexpr int INW = 5632;
constexpr int C_Q = 0, C_K = 1024, C_V = 1280, C_XR = 1536, C_YR = 2560, C_GA = 3584, C_GR = 4608;
constexpr int NEXP = 16, NGRP = 4, EPG = 4, FF = 512;
constexpr float EPS = 1e-6f;
constexpr float LOG2E = 1.4426950408889634f;
constexpr float QSCALE = 0.08838834764831845f * LOG2E;

constexpr size_t MiB = 1u << 20;
constexpr size_t WS_CTL = 0, CTL_ZERO_BYTES = 1 * MiB;
constexpr size_t WS_WIN = 1 * MiB;
constexpr size_t WS_WATT = 12 * MiB, WS_WREC = 14 * MiB, WS_WOUT = 16 * MiB;
constexpr size_t WS_WGU = 18 * MiB;
constexpr size_t WS_WD = 50 * MiB;
constexpr size_t WS_WLRU = 66 * MiB;
constexpr size_t WS_XN = 18 * MiB;
constexpr size_t WS_Q = 67 * MiB;
constexpr size_t WS_K = 99 * MiB;
constexpr size_t WS_V = 107 * MiB + 512 * 1024;
constexpr size_t WS_XR = 116 * MiB;
constexpr size_t WS_GY = 148 * MiB + 512 * 1024;
constexpr size_t WS_GA = 180 * MiB + 512 * 1024;
constexpr size_t WS_GR = 212 * MiB + 512 * 1024;
constexpr size_t WS_LIST = 244 * MiB + 512 * 1024;
constexpr size_t WS_WLIST = 245 * MiB + 512 * 1024;
constexpr size_t WS_SUM = 246 * MiB + 512 * 1024;
constexpr size_t WS_END = 248 * MiB;
constexpr int CW_TMO = 0, CW_CODE = 1, CW_BAR = 4096, CW_CNT = 8192;

constexpr int RING_BYTES = 131072;
constexpr int LDSCTL_OFF = RING_BYTES, MISC_OFF = LDSCTL_OFF + 320;
constexpr int LDS_BYTES = 147456;
constexpr int NWAVES = 8, NTHREADS = 512;

#define RLX_AGENT __ATOMIC_RELAXED, __HIP_MEMORY_SCOPE_AGENT
#define LDS_WAIT() asm volatile("s_waitcnt lgkmcnt(0)" ::: "memory")
#define VM_WAIT() asm volatile("s_waitcnt vmcnt(0)" ::: "memory")

__device__ __forceinline__ unsigned f2bf(float f) { unsigned u = __builtin_bit_cast(unsigned, f); return (u + 0x7fffu + ((u >> 16) & 1u)) >> 16; }
__device__ __forceinline__ unsigned pk2(float lo, float hi) { return f2bf(lo) | (f2bf(hi) << 16); }
__device__ __forceinline__ float bf2f(unsigned short h) { return __builtin_bit_cast(float, (unsigned)h << 16); }
__device__ __forceinline__ float bflo(unsigned w) { return __builtin_bit_cast(float, w << 16); }
__device__ __forceinline__ float bfhi(unsigned w) { return __builtin_bit_cast(float, w & 0xffff0000u); }
__device__ __forceinline__ float wave_sum(float v) {
#pragma unroll
    for (int o = 1; o < 64; o <<= 1) v += __shfl_xor(v, o);
    return v;
}
__device__ __forceinline__ float wave_max(float v) {
#pragma unroll
    for (int o = 1; o < 64; o <<= 1) v = fmaxf(v, __shfl_xor(v, o));
    return v;
}
__device__ __forceinline__ float sigmoidf_(float x) { return 1.f / (1.f + __expf(-x)); }
__device__ __forceinline__ float gelu_tanh(float x) { const float u = 0.7978845608028654f * (x + 0.044715f * x * x * x); return x / (1.f + __expf(-2.f * u)); }

#define XB_TMO      128
#define XB_XCNT(j)  (256  + 64 * (j))
#define XB_XSUB(j)  (1280 + 64 * (j))
#define XB_XGEN(j)  (2304 + 64 * (j))
#define XB_TOP      3328
#define XB_TOPGEN   3392
#define XCD_BAR_WORDS 3456
#define XB_SPIN_CAP (1u << 24)
__device__ __forceinline__ unsigned xb_ld(unsigned* p)              { return __hip_atomic_load(p, __ATOMIC_RELAXED, __HIP_MEMORY_SCOPE_AGENT); }
__device__ __forceinline__ unsigned xb_add(unsigned* p, unsigned v) { return __hip_atomic_fetch_add(p, v, __ATOMIC_RELAXED, __HIP_MEMORY_SCOPE_AGENT); }
__device__ __forceinline__ unsigned xb_xcc_id() { return (unsigned)__builtin_amdgcn_s_getreg((3 << 11) | 20) & 0xFu; }
#define XB_SPIN(cond, bar) do { unsigned _sp = 0; while (cond) { __builtin_amdgcn_s_sleep(1); \
    if ((++_sp & 255u) == 0u) { if (xb_ld(&(bar)[XB_TMO])) break; if (_sp > XB_SPIN_CAP) { atomicAdd(&(bar)[XB_TMO], 1u); break; } } } } while (0)
struct XcdBarrier { unsigned* bar; unsigned x; volatile LAS unsigned* st; };
__device__ __forceinline__ XcdBarrier xcd_barrier_post(unsigned* bar, volatile LAS unsigned* st) {
    XcdBarrier b; b.bar = bar; b.x = xb_xcc_id(); b.st = st;
    if (threadIdx.x == 0) (void)xb_add(&bar[XB_XCNT(b.x)], 1u);
    return b;
}
__device__ __forceinline__ void xcd_barrier_complete(unsigned* bar, unsigned x, unsigned& nloc, unsigned& nx) {
    const unsigned G = gridDim.x * gridDim.y * gridDim.z;
    unsigned sum, cnt, mine, sp = 0u;
    for (;;) {
        sum = 0u; cnt = 0u; mine = 0u;
#pragma unroll
        for (unsigned j = 0; j < 16; ++j) { const unsigned c = xb_ld(&bar[XB_XCNT(j)]); sum += c; cnt += (c > 0u) ? 1u : 0u; mine = (j == x) ? c : mine; }
        if (sum == G) break;
        __builtin_amdgcn_s_sleep(1);
        if ((++sp & 255u) == 0u) { if (xb_ld(&bar[XB_TMO])) break; if (sp > XB_SPIN_CAP) { atomicAdd(&bar[XB_TMO], 1u); break; } }
    }
    nloc = mine > 0u ? mine : 1u; nx = cnt > 0u ? cnt : 1u;
}
__device__ __forceinline__ void xcd_barrier(const XcdBarrier& b) {
    asm volatile("s_waitcnt vmcnt(0)" ::: "memory");
    __syncthreads();
    if (threadIdx.x == 0) {
        unsigned* bar = b.bar;
        __builtin_amdgcn_s_waitcnt(0);
        unsigned nloc = b.st[0], nx = b.st[1];
        if (nloc == 0u) { xcd_barrier_complete(bar, b.x, nloc, nx); b.st[0] = nloc; b.st[1] = nx; }
        const unsigned old = xb_add(&bar[XB_XSUB(b.x)], 1u);
        const unsigned gen = old / nloc;
        if (old + 1u == (gen + 1u) * nloc) {
            __builtin_amdgcn_fence(__ATOMIC_RELEASE, "agent");
            asm volatile("s_waitcnt vmcnt(0)" ::: "memory");
            const unsigned og = xb_add(&bar[XB_TOP], 1u);
            const unsigned tg = og / nx;
            if (og + 1u == (tg + 1u) * nx) xb_add(&bar[XB_TOPGEN], 1u);
            else XB_SPIN(xb_ld(&bar[XB_TOPGEN]) == tg, bar);
            __builtin_amdgcn_fence(__ATOMIC_ACQUIRE, "agent");
            xb_add(&bar[XB_XGEN(b.x)], 1u);
            asm volatile("s_waitcnt vmcnt(0)" ::: "memory");
        } else {
            XB_SPIN(xb_ld(&bar[XB_XGEN(b.x)]) == gen, bar);
            __builtin_amdgcn_fence(__ATOMIC_ACQUIRE, "agent");
            asm volatile("s_waitcnt vmcnt(0)" ::: "memory");
        }
    }
    __syncthreads();
}

struct Args { const float* in[24]; float* out; unsigned char* ws; int ph_lo, ph_hi, use_bar, pad; };
struct Frame {
    LAS unsigned char* lds;
    volatile LAS unsigned* MISC;
    gu32* ctl;
    int tid, lane, wave, vcu, G;
    float* out; unsigned char* ws;
};
#define I_X 0
#define I_META 1
#define I_GMIX 2
#define I_WIN 3
#define I_CONVW 4
#define I_CONVB 5
#define I_LWA 6
#define I_LBA 7
#define I_LWX 8
#define I_LBX 9
#define I_LAM 10
#define I_SINK 11
#define I_WATT 12
#define I_WREC 13
#define I_WOUT 14
#define I_GFFN 15
#define I_WGRP 16
#define I_BGRP 17
#define I_WRT 18
#define I_BRT 19
#define I_MWG 20
#define I_MWU 21
#define I_MWD 22
#define I_GFIN 23

__device__ __forceinline__ void refresh(Frame& F) { int t = threadIdx.x; asm volatile("" : "+v"(t)); F.tid = t; F.lane = t & 63; F.wave = __builtin_amdgcn_readfirstlane(t >> 6); }
__device__ __forceinline__ void transpose_item(const float* W, int ldw, int k0, int n0, bf16* WT, int ldt, int drow0, int dk0, float scale, LAS float* scr, int lane) {
#pragma unroll 8
    for (int i = 0; i < 32; ++i) { const int kk = 2 * i + (lane >> 5); scr[kk * 33 + (lane & 31)] = W[(size_t)(k0 + kk) * ldw + n0 + (lane & 31)] * scale; }
    LDS_WAIT(); asm volatile("" ::: "memory");
    const int c = lane & 7;
#pragma unroll
    for (int j = 0; j < 4; ++j) { const int n = (lane >> 3) + 8 * j; const LAS float* s = scr + (8 * c) * 33 + n;
        v4u o; o.x = pk2(s[0 * 33], s[1 * 33]); o.y = pk2(s[2 * 33], s[3 * 33]); o.z = pk2(s[4 * 33], s[5 * 33]); o.w = pk2(s[6 * 33], s[7 * 33]);
        *(GAS v4u*)(WT + (size_t)(drow0 + n) * ldt + dk0 + 8 * c) = o; }
    LDS_WAIT(); asm volatile("" ::: "memory");
}
template <int PART> __device__ __forceinline__ void p0_prologue(Frame& F, const Args& A) {
    LAS float* scr = (LAS float*)(F.lds + F.wave * 16384);
    const int gw = F.vcu * NWAVES + F.wave, NGW = F.G * NWAVES, lane = F.lane;
    unsigned char* ws = F.ws;
    constexpr int I_IN = 16 * 176, I_SQ = 16 * 32, I_LRU = 32 * 8, I_MG = 16 * 16, I_MD = 8 * 32;
    constexpr int NITEMS = I_IN + 3 * I_SQ + I_LRU + NEXP * (2 * I_MG + I_MD);
    constexpr int NA = I_IN + 3 * I_SQ + I_LRU;
    for (int it = (PART == 0 ? 0 : NA) + gw; it < (PART == 0 ? NA : NITEMS); it += NGW) {
        int r = it;
        if (r < I_IN) { const int kb = r / 176, nb = r % 176; transpose_item(A.in[I_WIN], INW, 64 * kb, 32 * nb, (bf16*)(ws + WS_WIN), D, 32 * nb, 64 * kb, 1.f, scr, lane); continue; } r -= I_IN;
        if (r < 3 * I_SQ) { const int w = r / I_SQ, q = r % I_SQ, kb = q / 32, nb = q % 32;
            const float* W = w == 0 ? A.in[I_WATT] : (w == 1 ? A.in[I_WREC] : A.in[I_WOUT]); bf16* WT = (bf16*)(ws + (w == 0 ? WS_WATT : (w == 1 ? WS_WREC : WS_WOUT)));
            transpose_item(W, D, 64 * kb, 32 * nb, WT, D, 32 * nb, 64 * kb, 1.f, scr, lane); continue; } r -= 3 * I_SQ;
        if (r < I_LRU) { const int mat = r / 8, q = r % 8, kb = q / 4, nb = q % 4; const int dir = mat >> 4, gate = (mat >> 3) & 1, n = mat & 7;
            const float* W = (gate ? A.in[I_LWX] : A.in[I_LWA]) + (size_t)(dir * 8 + n) * 128 * 128;
            transpose_item(W, 128, 64 * kb, 32 * nb, (bf16*)(ws + WS_WLRU) + (size_t)n * 512 * 128, 128, (dir * 2 + gate) * 128 + 32 * nb, 64 * kb, -LOG2E, scr, lane); continue; } r -= I_LRU;
        { const int e = r / (2 * I_MG + I_MD); int q = r % (2 * I_MG + I_MD);
          if (q < 2 * I_MG) { const int up = q / I_MG; q %= I_MG; const int kb = q / 16, nb = q % 16; const int n0 = 32 * nb;
              const float* W = (up ? A.in[I_MWU] : A.in[I_MWG]) + (size_t)e * D * FF;
              transpose_item(W, FF, 64 * kb, n0, (bf16*)(ws + WS_WGU) + (size_t)e * 1024 * 1024, D, (n0 >> 7) * 256 + (n0 & 127) + up * 128, 64 * kb, 1.f, scr, lane); }
          else { q -= 2 * I_MG; const int kb = q / 32, nb = q % 32;
              transpose_item(A.in[I_MWD] + (size_t)e * FF * D, D, 64 * kb, 32 * nb, (bf16*)(ws + WS_WD) + (size_t)e * 1024 * 512, FF, 32 * nb, 64 * kb, 1.f, scr, lane); } }
    }
    if (PART != 0) return;
    bf16* XN = (bf16*)(F.ws + WS_XN);
    const GAS f32x4* g4 = (const GAS f32x4*)A.in[I_GMIX] + lane;
    for (int m = gw; m < MPAD; m += NGW) {
        GAS v2u* o8 = (GAS v2u*)(XN + (size_t)m * D) + lane;
        if (m >= MROWS) {
#pragma unroll
            for (int j = 0; j < 4; ++j) o8[64 * j] = (v2u){0u, 0u};
            continue; }
        const float* xrow = m < MREAL ? A.in[I_X] + (size_t)m * D : A.in[I_META] + (size_t)(m - MREAL) * D;
        const GAS f32x4* xr = (const GAS f32x4*)xrow + lane;
        f32x4 v[4]; float s = 0.f;
#pragma unroll
        for (int j = 0; j < 4; ++j) { v[j] = xr[64 * j]; s += (v[j].x * v[j].x + v[j].y * v[j].y) + (v[j].z * v[j].z + v[j].w * v[j].w); }
        const float rstd = 1.f / sqrtf(wave_sum(s) * (1.f / D) + EPS);
#pragma unroll
        for (int j = 0; j < 4; ++j) { const f32x4 g = g4[64 * j]; o8[64 * j] = (v2u){pk2(v[j].x * rstd * g.x, v[j].y * rstd * g.y), pk2(v[j].z * rstd * g.z, v[j].w * rstd * g.w)}; }
    }
}

__device__ __forceinline__ void wave_gemm32(const bf16* a0, const bf16* a1, const bf16* b0, const bf16* b1, int K, f32x4 (&acc)[2][2]) {
    for (int k0 = 0; k0 < K; k0 += 32) {
        const bf16x8 A0 = *(const bf16x8*)(a0 + k0), A1 = *(const bf16x8*)(a1 + k0), B0 = *(const bf16x8*)(b0 + k0), B1 = *(const bf16x8*)(b1 + k0);
        acc[0][0] = __builtin_amdgcn_mfma_f32_16x16x32_bf16(A0, B0, acc[0][0], 0, 0, 0);
        acc[0][1] = __builtin_amdgcn_mfma_f32_16x16x32_bf16(A0, B1, acc[0][1], 0, 0, 0);
        acc[1][0] = __builtin_amdgcn_mfma_f32_16x16x32_bf16(A1, B0, acc[1][0], 0, 0, 0);
        acc[1][1] = __builtin_amdgcn_mfma_f32_16x16x32_bf16(A1, B1, acc[1][1], 0, 0, 0);
    }
}
#define ZERO_ACC(acc) do { _Pragma("unroll") for (int _i = 0; _i < 2; ++_i) _Pragma("unroll") for (int _j = 0; _j < 2; ++_j) acc[_i][_j] = (f32x4){0.f, 0.f, 0.f, 0.f}; } while (0)

__device__ __forceinline__ void p1_store(unsigned char* ws, int row, int col, float v) {
    if (col < C_K) { if (row < MREAL) ((bf16*)(ws + WS_Q))[(size_t)row * D + col] = (bf16)f2bf(v * QSCALE); }
    else if (col < C_V) ((bf16*)(ws + WS_K))[(size_t)row * KVW + (col - C_K)] = (bf16)f2bf(v);
    else if (col < C_XR) ((bf16*)(ws + WS_V))[(size_t)row * KVW + (col - C_V)] = (bf16)f2bf(v);
    else if (col < C_YR) ((bf16*)(ws + WS_XR))[(size_t)row * D + (col - C_XR)] = (bf16)f2bf(v);
    else if (col < C_GA) { if (row < MREAL) ((bf16*)(ws + WS_GY))[(size_t)row * D + (col - C_YR)] = (bf16)f2bf(gelu_tanh(v)); }
    else if (col < C_GR) { if (row < MREAL) ((bf16*)(ws + WS_GA))[(size_t)row * D + (col - C_GA)] = (bf16)f2bf(sigmoidf_(v)); }
    else { if (row < MREAL) ((bf16*)(ws + WS_GR))[(size_t)row * D + (col - C_GR)] = (bf16)f2bf(sigmoidf_(v)); }
}
__device__ __forceinline__ void p1_simple(Frame& F, const Args& A, int tn_lo = 0, int tn_hi = 176) {
    const int gw = F.vcu * NWAVES + F.wave, NGW = F.G * NWAVES, lane = F.lane, fr = lane & 15, fq = lane >> 4;
    const bf16* XN = (const bf16*)(F.ws + WS_XN); const bf16* WT = (const bf16*)(F.ws + WS_WIN);
    constexpr int NTM = 513, NTN = INW / 32;
    for (int it = gw; it < NTM * NTN; it += NGW) {
        const int tm = it / NTN, tn = it % NTN, m0 = tm * 32, n0 = tn * 32;
        if (tn < tn_lo || tn >= tn_hi) continue;
        f32x4 acc[2][2]; ZERO_ACC(acc);
        wave_gemm32(XN + (size_t)(m0 + fr) * D + 8 * fq, XN + (size_t)(m0 + 16 + fr) * D + 8 * fq, WT + (size_t)(n0 + fr) * D + 8 * fq, WT + (size_t)(n0 + 16 + fr) * D + 8 * fq, D, acc);
#pragma unroll
        for (int i = 0; i < 2; ++i)
#pragma unroll
            for (int j = 0; j < 2; ++j)
#pragma unroll
                for (int r = 0; r < 4; ++r) p1_store(F.ws, m0 + 16 * i + 4 * fq + r, n0 + 16 * j + fr, acc[i][j][r]);
    }
}

__device__ __forceinline__ void attn_simple(Frame& F, const Args& A) {
    const int gw = F.vcu * NWAVES + F.wave, NGW = F.G * NWAVES, lane = F.lane;
    bf16* Q = (bf16*)(F.ws + WS_Q); const bf16* Kb = (const bf16*)(F.ws + WS_K); const bf16* Vb = (const bf16*)(F.ws + WS_V);
    LAS float* sc = (LAS float*)(F.lds + F.wave * 2048);
    for (int it = gw; it < MREAL * NHEAD; it += NGW) {
        const int r = it >> 3, h = it & 7, b = r / SEQ, s = r % SEQ, kv = h >> 2;
        const float slope2 = exp2f(-(float)(h + 1)) * LOG2E;
        const float sink2 = A.in[I_SINK][h] * LOG2E;
        const unsigned qw = *(const unsigned*)(Q + (size_t)r * D + h * HD + 2 * lane);
        const float q0 = bflo(qw), q1 = bfhi(qw);
        const int s_lo = s - 128 < 0 ? 0 : s - 128, s_hi = s + 128 > SEQ - 1 ? SEQ - 1 : s + 128, nb = s_hi - s_lo + 1, tot = nb + NMETA;
        for (int j = 0; j < tot; ++j) {
            const int krow = j < nb ? b * SEQ + s_lo + j : MREAL + (j - nb);
            const unsigned kw = *(const unsigned*)(Kb + (size_t)krow * KVW + kv * HD + 2 * lane);
            float d = wave_sum(q0 * bflo(kw) + q1 * bfhi(kw));
            if (j < nb) { const int dd = s_lo + j - s; d -= slope2 * (float)(dd < 0 ? -dd : dd); }
            if (lane == 0) sc[j] = d;
        }
        LDS_WAIT(); asm volatile("" ::: "memory");
        float mx = sink2;
        for (int j = lane; j < tot; j += 64) mx = fmaxf(mx, sc[j]);
        mx = wave_max(mx);
        float ls = 0.f;
        for (int j = lane; j < tot; j += 64) { const float p = exp2f(sc[j] - mx); sc[j] = p; ls += p; }
        ls = wave_sum(ls) + exp2f(sink2 - mx);
        LDS_WAIT(); asm volatile("" ::: "memory");
        float o0 = 0.f, o1 = 0.f;
        for (int j = 0; j < tot; ++j) {
            const int krow = j < nb ? b * SEQ + s_lo + j : MREAL + (j - nb);
            const unsigned vw = *(const unsigned*)(Vb + (size_t)krow * KVW + kv * HD + 2 * lane);
            const float p = sc[j]; o0 += p * bflo(vw); o1 += p * bfhi(vw);
        }
        const float il = 1.f / ls;
        *(unsigned*)(Q + (size_t)r * D + h * HD + 2 * lane) = pk2(o0 * il, o1 * il);
        LDS_WAIT(); asm volatile("" ::: "memory");
    }
}

__device__ __forceinline__ int trow(int b, int t) { return t < NMETA ? MREAL + t : b * SEQ + (t - NMETA); }
__device__ __forceinline__ void scan_simple(Frame& F, const Args& A) {
    if (F.vcu >= 16) return;
    const int b = F.vcu >> 3, n = F.vcu & 7, tid = F.tid;
    const int e = tid & 127, gate = (tid >> 7) & 1, kh = tid >> 8;
    LAS float* xcs = (LAS float*)F.lds;
    LAS float* pp = (LAS float*)(F.lds + 8192);
    const bf16* XR = (const bf16*)(F.ws + WS_XR); bf16* GY = (bf16*)(F.ws + WS_GY); float* HF = F.out;
    const float* cw = A.in[I_CONVW]; const float* cb = A.in[I_CONVB];
    for (int dir = 0; dir < 2; ++dir) {
        float w[64];
        { const float* W = (gate ? A.in[I_LWX] : A.in[I_LWA]) + (size_t)(dir * 8 + n) * 128 * 128 + (size_t)(64 * kh) * 128 + e;
#pragma unroll
          for (int dd = 0; dd < 64; ++dd) w[dd] = W[dd * 128]; }
        const int ch = 128 * n + e;
        const float ba = A.in[I_LBA][dir * D + ch], bx = A.in[I_LBX][dir * D + ch], lam = A.in[I_LAM][dir * D + ch];
        const float sp8 = 8.f * log1pf(__expf(-lam));
        float h = 0.f;
        for (int ci = 0; ci < TLEN / 16; ++ci) {
            const int c = dir ? (TLEN / 16 - 1 - ci) : ci, t0 = 16 * c;
            for (int idx = tid; idx < 2048; idx += NTHREADS) { const int tt = idx >> 7, cc = idx & 127, t = t0 + tt, gc = 128 * n + cc;
                float a = cb[gc];
#pragma unroll
                for (int j = 0; j < 4; ++j) { const int ts = t - 2 + j; if (ts >= 0 && ts < TLEN) a += cw[j * D + gc] * bf2f(XR[(size_t)trow(b, ts) * D + gc]); }
                xcs[idx] = a; }
            __syncthreads();
            for (int tt = 0; tt < 16; ++tt) { float p = 0.f; const LAS float* xs = xcs + tt * 128 + 64 * kh;
#pragma unroll
                for (int dd = 0; dd < 64; ++dd) p += w[dd] * xs[dd];
                pp[((kh * 2 + gate) * 16 + tt) * 128 + e] = p; }
            __syncthreads();
            if (tid < 128) {
                for (int k = 0; k < 16; ++k) { const int tt = dir ? 15 - k : k, t = t0 + tt;
                    const float pa = pp[((0 * 2 + 0) * 16 + tt) * 128 + e] + pp[((1 * 2 + 0) * 16 + tt) * 128 + e] + ba;
                    const float px = pp[((0 * 2 + 1) * 16 + tt) * 128 + e] + pp[((1 * 2 + 1) * 16 + tt) * 128 + e] + bx;
                    const float rg = sigmoidf_(pa), ig = sigmoidf_(px);
                    const float la = -sp8 * rg, a = __expf(la), u = sqrtf(-expm1f(2.f * la)) * (ig * xcs[tt * 128 + e]);
                    h = a * h + u;
                    if (t >= NMETA) { const size_t off = (size_t)(b * SEQ + t - NMETA) * D + ch;
                        if (dir == 0) HF[off] = h;
                        else GY[off] = (bf16)f2bf((HF[off] + h) * bf2f(GY[off])); } }
            }
            __syncthreads();
        }
        VM_WAIT(); __syncthreads();
    }
}

__device__ __forceinline__ void merge_simple(Frame& F, const Args& A) {
    const int gw = F.vcu * NWAVES + F.wave, NGW = F.G * NWAVES, lane = F.lane, fr = lane & 15, fq = lane >> 4;
    const bf16* AO = (const bf16*)(F.ws + WS_Q); const bf16* REC = (const bf16*)(F.ws + WS_GY);
    const bf16* WA = (const bf16*)(F.ws + WS_WATT); const bf16* WR = (const bf16*)(F.ws + WS_WREC);
    const bf16* GA = (const bf16*)(F.ws + WS_GA); const bf16* GR = (const bf16*)(F.ws + WS_GR); bf16* M = (bf16*)(F.ws + WS_XR);
    for (int it = gw; it < 512 * 32; it += NGW) {
        const int m0 = (it >> 5) * 32, n0 = (it & 31) * 32;
        f32x4 a1[2][2], a2[2][2]; ZERO_ACC(a1); ZERO_ACC(a2);
        wave_gemm32(AO + (size_t)(m0 + fr) * D + 8 * fq, AO + (size_t)(m0 + 16 + fr) * D + 8 * fq, WA + (size_t)(n0 + fr) * D + 8 * fq, WA + (size_t)(n0 + 16 + fr) * D + 8 * fq, D, a1);
        wave_gemm32(REC + (size_t)(m0 + fr) * D + 8 * fq, REC + (size_t)(m0 + 16 + fr) * D + 8 * fq, WR + (size_t)(n0 + fr) * D + 8 * fq, WR + (size_t)(n0 + 16 + fr) * D + 8 * fq, D, a2);
#pragma unroll
        for (int i = 0; i < 2; ++i)
#pragma unroll
            for (int j = 0; j < 2; ++j)
#pragma unroll
                for (int r = 0; r < 4; ++r) { const size_t off = (size_t)(m0 + 16 * i + 4 * fq + r) * D + n0 + 16 * j + fr;
                    M[off] = (bf16)f2bf(bf2f(GA[off]) * a1[i][j][r] + bf2f(GR[off]) * a2[i][j][r]); }
    }
}
__device__ __forceinline__ void wout_simple(Frame& F, const Args& A) {
    const int gw = F.vcu * NWAVES + F.wave, NGW = F.G * NWAVES, lane = F.lane, fr = lane & 15, fq = lane >> 4;
    const bf16* M = (const bf16*)(F.ws + WS_XR); const bf16* WO = (const bf16*)(F.ws + WS_WOUT);
    for (int it = gw; it < 512 * 32; it += NGW) {
        const int m0 = (it >> 5) * 32, n0 = (it & 31) * 32;
        f32x4 acc[2][2]; ZERO_ACC(acc);
        wave_gemm32(M + (size_t)(m0 + fr) * D + 8 * fq, M + (size_t)(m0 + 16 + fr) * D + 8 * fq, WO + (size_t)(n0 + fr) * D + 8 * fq, WO + (size_t)(n0 + 16 + fr) * D + 8 * fq, D, acc);
#pragma unroll
        for (int i = 0; i < 2; ++i)
#pragma unroll
            for (int j = 0; j < 2; ++j)
#pragma unroll
                for (int r = 0; r < 4; ++r) { const size_t off = (size_t)(m0 + 16 * i + 4 * fq + r) * D + n0 + 16 * j + fr; F.out[off] = A.in[I_X][off] + acc[i][j][r]; }
    }
}
__device__ __forceinline__ void route_simple(Frame& F, const Args& A) {
    const int gw = F.vcu * NWAVES + F.wave, NGW = F.G * NWAVES, lane = F.lane;
    bf16* N2 = (bf16*)(F.ws + WS_Q);
    unsigned* LIST = (unsigned*)(F.ws + WS_LIST); float* WLIST = (float*)(F.ws + WS_WLIST);
    const GAS f32x4* g4 = (const GAS f32x4*)A.in[I_GFFN] + lane;
    const f32x4* wg4 = (const f32x4*)A.in[I_WGRP]; const f32x4* wr4 = (const f32x4*)A.in[I_WRT];
    for (int m = gw; m < MREAL; m += NGW) {
        const GAS f32x4* hr = (const GAS f32x4*)(F.out + (size_t)m * D) + lane;
        f32x4 v[4]; float s = 0.f;
#pragma unroll
        for (int j = 0; j < 4; ++j) { v[j] = hr[64 * j]; s += (v[j].x * v[j].x + v[j].y * v[j].y) + (v[j].z * v[j].z + v[j].w * v[j].w); }
        const float rstd = 1.f / sqrtf(wave_sum(s) * (1.f / D) + EPS);
        GAS v2u* o8 = (GAS v2u*)(N2 + (size_t)m * D) + lane;
        float lg[20];
#pragma unroll
        for (int o = 0; o < 20; ++o) lg[o] = 0.f;
#pragma unroll
        for (int j = 0; j < 4; ++j) { const f32x4 g = g4[64 * j]; v[j].x *= rstd * g.x; v[j].y *= rstd * g.y; v[j].z *= rstd * g.z; v[j].w *= rstd * g.w;
            o8[64 * j] = (v2u){pk2(v[j].x, v[j].y), pk2(v[j].z, v[j].w)};
#pragma unroll
            for (int i = 0; i < 4; ++i) { const int col = 256 * j + 4 * lane + i; const float x = v[j][i];
                const f32x4 a = wg4[col]; lg[0] += x * a.x; lg[1] += x * a.y; lg[2] += x * a.z; lg[3] += x * a.w;
#pragma unroll
                for (int q = 0; q < 4; ++q) { const f32x4 c = wr4[col * 4 + q]; lg[4 + 4 * q] += x * c.x; lg[5 + 4 * q] += x * c.y; lg[6 + 4 * q] += x * c.z; lg[7 + 4 * q] += x * c.w; } } }
#pragma unroll
        for (int o = 0; o < 20; ++o) lg[o] = wave_sum(lg[o]);
        if (lane == 0) {
            float gl[4]; int gi = 0;
#pragma unroll
            for (int o = 0; o < 4; ++o) gl[o] = lg[o] + A.in[I_BGRP][o];
            float gm = gl[0];
#pragma unroll
            for (int o = 1; o < 4; ++o) if (gl[o] > gm) { gm = gl[o]; gi = o; }
            float gs = 0.f;
#pragma unroll
            for (int o = 0; o < 4; ++o) gs += __expf(gl[o] - gm);
            const float gp = 1.f / gs;
            float el[4];
#pragma unroll
            for (int o = 0; o < 4; ++o) { float x = 0.f;
#pragma unroll
                for (int g = 0; g < 4; ++g) x = (g == gi) ? lg[4 + 4 * g + o] + A.in[I_BRT][4 * g + o] : x;
                el[o] = x; }
            int i1 = 0; float e1 = el[0];
#pragma unroll
            for (int o = 1; o < 4; ++o) if (el[o] > e1) { e1 = el[o]; i1 = o; }
            int i2 = -1; float e2 = -3.0e38f;
#pragma unroll
            for (int o = 0; o < 4; ++o) if (o != i1 && el[o] > e2) { e2 = el[o]; i2 = o; }
            const float w1 = gp / (1.f + __expf(e2 - e1)), w2 = gp - w1;
            const int x1 = gi * EPG + i1, x2 = gi * EPG + i2;
            const unsigned p1 = atomicAdd((unsigned*)(F.ctl + CW_CNT + 64 * x1), 1u), p2 = atomicAdd((unsigned*)(F.ctl + CW_CNT + 64 * x2), 1u);
            LIST[x1 * MREAL + p1] = (unsigned)m; WLIST[x1 * MREAL + p1] = w1;
            LIST[x2 * MREAL + p2] = (unsigned)m | (1u << 14); WLIST[x2 * MREAL + p2] = w2;
        }
    }
}
struct ExpMap { int cnt[NEXP]; int off[NEXP]; };
__device__ __forceinline__ void moe1_simple(Frame& F, const Args& A) {
    const int gw = F.vcu * NWAVES + F.wave, NGW = F.G * NWAVES, lane = F.lane, fr = lane & 15, fq = lane >> 4;
    const bf16* N2 = (const bf16*)(F.ws + WS_Q); const unsigned* LIST = (const unsigned*)(F.ws + WS_LIST); bf16* HDN = (bf16*)(F.ws + WS_XR);
    int base = 0, off = 0;
    for (int e = 0; e < NEXP; ++e) {
        const int cnt = (int)__hip_atomic_load(F.ctl + CW_CNT + 64 * e, RLX_AGENT);
        const int ntm = (cnt + 31) >> 5, nit = ntm * 16;
        const bf16* WG = (const bf16*)(F.ws + WS_WGU) + (size_t)e * 1024 * 1024;
        int first = gw - (base % NGW); if (first < 0) first += NGW;
        for (int q = first; q < nit; q += NGW) {
            const int tm = q >> 4, tn = q & 15, j0 = 32 * tn;
            int i0 = tm * 32 + fr, i1 = i0 + 16; if (i0 >= cnt) i0 = 0; if (i1 >= cnt) i1 = 0;
            const int t0 = LIST[e * MREAL + i0] & 0x3fff, t1 = LIST[e * MREAL + i1] & 0x3fff;
            const int br = (j0 >> 7) * 256 + (j0 & 127);
            f32x4 ag[2][2], au[2][2]; ZERO_ACC(ag); ZERO_ACC(au);
            wave_gemm32(N2 + (size_t)t0 * D + 8 * fq, N2 + (size_t)t1 * D + 8 * fq, WG + (size_t)(br + fr) * D + 8 * fq, WG + (size_t)(br + 16 + fr) * D + 8 * fq, D, ag);
            wave_gemm32(N2 + (size_t)t0 * D + 8 * fq, N2 + (size_t)t1 * D + 8 * fq, WG + (size_t)(br + 128 + fr) * D + 8 * fq, WG + (size_t)(br + 144 + fr) * D + 8 * fq, D, au);
#pragma unroll
            for (int i = 0; i < 2; ++i)
#pragma unroll
                for (int j = 0; j < 2; ++j)
#pragma unroll
                    for (int r = 0; r < 4; ++r) { const int ii = tm * 32 + 16 * i + 4 * fq + r; const float g = ag[i][j][r], u = au[i][j][r];
                        HDN[(size_t)(off + ii) * FF + j0 + 16 * j + fr] = (bf16)f2bf(g / (1.f + __expf(-g)) * u); }
        }
        base += nit; off += (cnt + 255) & ~255;
    }
}
__device__ __forceinline__ void moe2_simple(Frame& F, const Args& A) {
    const int gw = F.vcu * NWAVES + F.wave, NGW = F.G * NWAVES, lane = F.lane, fr = lane & 15, fq = lane >> 4;
    const unsigned* LIST = (const unsigned*)(F.ws + WS_LIST); const float* WLIST = (const float*)(F.ws + WS_WLIST);
    const bf16* HDN = (const bf16*)(F.ws + WS_XR); bf16* Y = (bf16*)(F.ws + WS_GA);
    int base = 0, off = 0;
    for (int e = 0; e < NEXP; ++e) {
        const int cnt = (int)__hip_atomic_load(F.ctl + CW_CNT + 64 * e, RLX_AGENT);
        const int ntm = (cnt + 31) >> 5, nit = ntm * 32;
        const bf16* WD = (const bf16*)(F.ws + WS_WD) + (size_t)e * 1024 * 512;
        int first = gw - (base % NGW); if (first < 0) first += NGW;
        for (int q = first; q < nit; q += NGW) {
            const int tm = q >> 5, tn = q & 31, n0 = 32 * tn;
            f32x4 acc[2][2]; ZERO_ACC(acc);
            const bf16* a0 = HDN + (size_t)(off + tm * 32 + fr) * FF + 8 * fq;
            wave_gemm32(a0, a0 + 16 * FF, WD + (size_t)(n0 + fr) * FF + 8 * fq, WD + (size_t)(n0 + 16 + fr) * FF + 8 * fq, FF, acc);
#pragma unroll
            for (int i = 0; i < 2; ++i)
#pragma unroll
                for (int r = 0; r < 4; ++r) { const int ii = tm * 32 + 16 * i + 4 * fq + r;
                    if (ii < cnt) { const unsigned le = LIST[e * MREAL + ii]; const float w = WLIST[e * MREAL + ii]; const size_t row = (size_t)(le >> 14) * MREAL + (le & 0x3fff);
#pragma unroll
                        for (int j = 0; j < 2; ++j) Y[row * D + n0 + 16 * j + fr] = (bf16)f2bf(w * acc[i][j][r]); } }
        }
        base += nit; off += (cnt + 255) & ~255;
    }
}
__device__ __forceinline__ void final_rows(Frame& F, const Args& A) {
    const int gw = F.vcu * NWAVES + F.wave, NGW = F.G * NWAVES, lane = F.lane;
    const bf16* Y = (const bf16*)(F.ws + WS_GA);
    const GAS f32x4* g4 = (const GAS f32x4*)A.in[I_GFIN] + lane;
    for (int m = gw; m < MREAL; m += NGW) {
        GAS f32x4* hr = (GAS f32x4*)(F.out + (size_t)m * D) + lane;
        const GAS v2u* y0 = (const GAS v2u*)(Y + (size_t)m * D) + lane; const GAS v2u* y1 = (const GAS v2u*)(Y + (size_t)(MREAL + m) * D) + lane;
        f32x4 v[4]; float s = 0.f;
#pragma unroll
        for (int j = 0; j < 4; ++j) { v[j] = hr[64 * j]; const v2u a = y0[64 * j], c = y1[64 * j];
            v[j].x += bflo(a.x) + bflo(c.x); v[j].y += bfhi(a.x) + bfhi(c.x); v[j].z += bflo(a.y) + bflo(c.y); v[j].w += bfhi(a.y) + bfhi(c.y);
            s += (v[j].x * v[j].x + v[j].y * v[j].y) + (v[j].z * v[j].z + v[j].w * v[j].w); }
        const float rstd = 1.f / sqrtf(wave_sum(s) * (1.f / D) + EPS);
#pragma unroll
        for (int j = 0; j < 4; ++j) { const f32x4 g = g4[64 * j]; hr[64 * j] = (f32x4){v[j].x * rstd * g.x, v[j].y * rstd * g.y, v[j].z * rstd * g.z, v[j].w * rstd * g.w}; }
    }
}


namespace pg8 {
constexpr int BM = 256, BK = 64, HALF = 128, HTB = HALF * BK * 2, STAGE_BYTES = 8 * HTB, NXCD = 8, WGM = 8;
__host__ __device__ __forceinline__ int lds_byte(int r, int c) { const int st = (r >> 4) * 2 + (c >> 5), rr = r & 15, cc = c & 31, ob = rr * 64 + cc * 2; return st * 1024 + (ob ^ (((ob >> 9) & 1) << 5)); }
__host__ __device__ __forceinline__ void stage_rc(int b, int& R, int& C) { const int st = b / 1024, sb = b % 1024, swz = sb ^ (((sb >> 9) & 1) << 5); R = (st >> 1) * 16 + swz / 64; C = (st & 1) * 32 + (swz % 64) / 2; }
__host__ __device__ __forceinline__ int perm32(int rho) { const int n = rho >> 4, i = rho & 15; return 8 * (i >> 2) + 4 * n + (i & 3); }
struct Unit { int pm, pn, e, cnt, off, slot; };
typedef float f32x2_t __attribute__((ext_vector_type(2))); typedef __bf16 bf16x2_t __attribute__((ext_vector_type(2)));
__device__ __forceinline__ unsigned cvt_pk_bf16(float lo, float hi) { f32x2_t v = {lo, hi}; bf16x2_t b = __builtin_convertvector(v, bf16x2_t); return __builtin_bit_cast(unsigned, b); }

struct StaticOrder {
    int nM, nN, nwg, G, c, K; const char* A; const char* Bt; int i0 = 0, nround = 1 << 30; bool dup_last = false;
    __device__ void init(const bf16* A_, const bf16* Bt_, int M, int N, int K_, int G_, int c_) { A = (const char*)A_; Bt = (const char*)Bt_; K = K_; nM = M / BM; nN = N / BM; nwg = nM * nN; G = G_; c = c_; }
    __device__ bool next(int i, Unit& u) const {
        if (i >= nround) return false;
        long L = (long)(i + i0) * G + c; if (L >= nwg) { if (!dup_last || L - G >= nwg) return false; L = c; }
        int wgid = (int)L; { const int q = nwg / NXCD, r = nwg % NXCD, xcd = wgid % NXCD, off = wgid / NXCD; wgid = (xcd < r ? xcd * (q + 1) : r * (q + 1) + (xcd - r) * q) + off; }
        const int nig = WGM * nN, gid = wgid / nig, fm = gid * WGM, gsz = (nM - fm) < WGM ? (nM - fm) : WGM;
        u.pm = fm + ((wgid % nig) % gsz); u.pn = (wgid % nig) / gsz; return true;
    }
    __device__ __forceinline__ const char* a_base(const Unit& u) const { return A + (size_t)u.pm * BM * K * 2; }
    __device__ __forceinline__ const char* b_base(const Unit& u) const { return Bt + (size_t)u.pn * BM * K * 2; }
    __device__ __forceinline__ void a_offsets(const Unit&, const int (&RA)[2], const int (&CA)[2], unsigned (&v)[2][2]) const {
#pragma unroll
        for (int h = 0; h < 2; ++h)
#pragma unroll
            for (int i = 0; i < 2; ++i) v[h][i] = (unsigned)((h * HALF + RA[i]) * K + CA[i]) * 2u; }
};

template <class Epi, class Sched, bool ALIGN_EPI>
__device__ __forceinline__ void gemm_phase(LAS unsigned char* lds, const int K, const Sched& S, const Epi& E) {
    int tid = threadIdx.x; asm volatile("" : "+v"(tid));
    const int wid = __builtin_amdgcn_readfirstlane(tid >> 6), lane = tid & 63, wr = wid >> 2, wc = wid & 3, fr = lane & 15, fq = lane >> 4;
    const int nt = K / BK;
    int RA[2], CA[2]; unsigned voffB[2];
#pragma unroll
    for (int i = 0; i < 2; ++i) { int R, C; stage_rc(tid * 16 + i * 8192, R, C); const int Rb = Epi::PERM ? ((R & ~31) + perm32(R & 31)) : R; RA[i] = R; CA[i] = C; voffB[i] = (unsigned)(Rb * K + C) * 2u; }
    const size_t kstep = (size_t)(BK * 2);
    const size_t hstep = (size_t)HALF * K * 2;
    const unsigned ldsw = (unsigned)wid * 1024u;
    const int aoff = lds_byte(wr * 64 + fr, fq * 8), boff = lds_byte(wc * 32 + fr, fq * 8);
#define PG8_SA(b, h) (((b) * 2 + (h)) * HTB)
#define PG8_SB(b, h) ((4 + (b) * 2 + (h)) * HTB)
#define PG8_STAGE2(bufoff, gbase, o0, o1) do { \
        __builtin_amdgcn_global_load_lds((const unsigned*)((const char*)(gbase) + (o0)), (LAS unsigned*)(lds + (bufoff) + ldsw), 16, 0, 0); \
        __builtin_amdgcn_global_load_lds((const unsigned*)((const char*)(gbase) + (o1)), (LAS unsigned*)(lds + (bufoff) + ldsw + 8192), 16, 0, 0); } while (0)
#define PG8_STB(b, h, gbase) PG8_STAGE2(PG8_SB(b, h), (gbase) + (h) * hstep, voffB[0], voffB[1])
#define PG8_LDA(dst, b, h) do { _Pragma("unroll") for (int m = 0; m < 4; ++m) _Pragma("unroll") for (int k = 0; k < 2; ++k) dst[m][k] = *(const LAS bf16x8*)(lds + PG8_SA(b, h) + aoff + m * 2048 + k * 1024); } while (0)
#define PG8_LDB(dst, b, h) do { _Pragma("unroll") for (int n = 0; n < 2; ++n) _Pragma("unroll") for (int k = 0; k < 2; ++k) dst[n][k] = *(const LAS bf16x8*)(lds + PG8_SB(b, h) + boff + n * 2048 + k * 1024); } while (0)
#define PG8_MMA(ai, bj, At, Bt) do { __builtin_amdgcn_s_setprio(1); _Pragma("unroll") for (int m = 0; m < 4; ++m) _Pragma("unroll") for (int n = 0; n < 2; ++n) _Pragma("unroll") for (int k = 0; k < 2; ++k) \
        acc[ai][bj][m][n] = __builtin_amdgcn_mfma_f32_16x16x32_bf16(Bt[n][k], At[m][k], acc[ai][bj][m][n], 0, 0, 0); __builtin_amdgcn_s_setprio(0); } while (0)
#define PG8_WAIT_V(n) asm volatile("s_waitcnt vmcnt(" #n ")" ::: "memory")
#define PG8_WAIT_L(n) asm volatile("s_waitcnt lgkmcnt(" #n ")" ::: "memory")
#define PG8_BAR __builtin_amdgcn_s_barrier()
#define PG8_SCHED __builtin_amdgcn_sched_barrier(0)
    Unit cur, nxt; int ui = 0;
    if (!S.next(0, cur)) return;
    f32x4 acc[2][2][4][2];
#pragma unroll
    for (int a = 0; a < 2; ++a)
#pragma unroll
        for (int b = 0; b < 2; ++b)
#pragma unroll
            for (int m = 0; m < 4; ++m)
#pragma unroll
                for (int n = 0; n < 2; ++n) acc[a][b][m][n] = (f32x4){0.f, 0.f, 0.f, 0.f};
    bf16x8 At[4][2], B0[2][2], B1[2][2];
    unsigned va[2][2], vn[2][2];
    S.a_offsets(cur, RA, CA, va);
    const char* cA = S.a_base(cur); const char* cB = S.b_base(cur);
    PG8_STB(0, 0, cB); PG8_STB(0, 1, cB); PG8_STAGE2(PG8_SA(0, 0), cA, va[0][0], va[0][1]); PG8_STAGE2(PG8_SA(0, 1), cA, va[1][0], va[1][1]);
    if (wr == 1) PG8_BAR;
    PG8_WAIT_V(2); PG8_BAR;
    PG8_STB(1, 0, cB + kstep); PG8_STAGE2(PG8_SA(1, 0), cA + kstep, va[0][0], va[0][1]); PG8_STB(1, 1, cB + kstep);
    PG8_WAIT_V(6); PG8_BAR;
    for (;;) {
        const bool has_next = S.next(ui + 1, nxt);
        const char* nA = cA; const char* nB = cB;
        if (has_next) { nA = S.a_base(nxt); nB = S.b_base(nxt); S.a_offsets(nxt, RA, CA, vn); }
        else {
#pragma unroll
            for (int h = 0; h < 2; ++h)
#pragma unroll
                for (int i = 0; i < 2; ++i) vn[h][i] = va[h][i]; }
        for (int t = 0; t < nt; t += 2) {
            const bool last = (t == nt - 2);
            const char* a1 = cA + (size_t)(t + 1) * kstep;
            const char* a2 = last ? nA : cA + (size_t)(t + 2) * kstep; const char* b2 = last ? nB : cB + (size_t)(t + 2) * kstep;
            const char* a3 = a2 + kstep; const char* b3 = b2 + kstep;
            const unsigned s00 = last ? vn[0][0] : va[0][0], s01 = last ? vn[0][1] : va[0][1], s10 = last ? vn[1][0] : va[1][0], s11 = last ? vn[1][1] : va[1][1];
            PG8_LDB(B0, 0, 0); PG8_LDB(B1, 0, 1); PG8_SCHED; PG8_LDA(At, 0, 0); PG8_STAGE2(PG8_SA(1, 1), a1, va[1][0], va[1][1]);
            PG8_WAIT_V(8); PG8_WAIT_L(0); PG8_BAR; PG8_MMA(0, 0, At, B0); PG8_MMA(0, 1, At, B1); PG8_BAR; PG8_SCHED;
            PG8_LDA(At, 0, 1); PG8_STB(0, 0, b2); PG8_STB(0, 1, b2); PG8_STAGE2(PG8_SA(0, 0), a2, s00, s01);
            PG8_WAIT_V(8); PG8_WAIT_L(0); PG8_BAR; PG8_MMA(1, 0, At, B0); PG8_MMA(1, 1, At, B1); PG8_BAR; PG8_SCHED;
            PG8_LDB(B0, 1, 0); PG8_LDB(B1, 1, 1); PG8_SCHED; PG8_LDA(At, 1, 0); PG8_STAGE2(PG8_SA(0, 1), a2, s10, s11);
            PG8_WAIT_V(8); PG8_WAIT_L(0); PG8_BAR; PG8_MMA(0, 0, At, B0); PG8_MMA(0, 1, At, B1); PG8_BAR; PG8_SCHED;
            PG8_LDA(At, 1, 1); PG8_STB(1, 0, b3); PG8_STB(1, 1, b3); PG8_STAGE2(PG8_SA(1, 0), a3, s00, s01);
            PG8_WAIT_V(8); PG8_WAIT_L(0); PG8_BAR; PG8_MMA(1, 0, At, B0); PG8_MMA(1, 1, At, B1); PG8_BAR; PG8_SCHED;
        }
        if constexpr (ALIGN_EPI) { if (wr == 0) PG8_BAR; }
        E(acc, cur, wr, wc, fr, fq);
        if (!has_next) break;
#pragma unroll
        for (int a = 0; a < 2; ++a)
#pragma unroll
            for (int b = 0; b < 2; ++b)
#pragma unroll
                for (int m = 0; m < 4; ++m)
#pragma unroll
                    for (int n = 0; n < 2; ++n) acc[a][b][m][n] = (f32x4){0.f, 0.f, 0.f, 0.f};
        cur = nxt; cA = nA; cB = nB; ++ui;
#pragma unroll
        for (int h = 0; h < 2; ++h)
#pragma unroll
            for (int i = 0; i < 2; ++i) va[h][i] = vn[h][i];
        if constexpr (ALIGN_EPI) { if (wr == 1) PG8_BAR; }
    }
    PG8_WAIT_V(0);
    if constexpr (!ALIGN_EPI) { if (wr == 0) PG8_BAR; }
    PG8_BAR;
#undef PG8_SA
#undef PG8_SB
#undef PG8_STAGE2
#undef PG8_STB
#undef PG8_LDA
#undef PG8_LDB
#undef PG8_MMA
#undef PG8_WAIT_V
#undef PG8_WAIT_L
#undef PG8_BAR
#undef PG8_SCHED
}

__device__ __forceinline__ float fast_sigmoid(float x) { return __builtin_amdgcn_rcpf(1.f + __builtin_amdgcn_exp2f(-LOG2E * x)); }
__device__ __forceinline__ float fast_gelu_tanh(float x) { const float u = x * (0.7978845608028654f + 0.035677408136300125f * x * x); return x * __builtin_amdgcn_rcpf(1.f + __builtin_amdgcn_exp2f(-2.f * LOG2E * u)); }
template <int ACT> __device__ __forceinline__ float actf(float v) { if (ACT == 1) return v * QSCALE; if (ACT == 2) return fast_gelu_tanh(v); if (ACT == 3) return fast_sigmoid(v); return v; }
template <int ACT> __device__ __forceinline__ void store_tile_bf16(const f32x4 (&acc)[2][2][4][2], bf16* base, int ld, int row0, int col0) {
#pragma unroll
    for (int ai = 0; ai < 2; ++ai)
#pragma unroll
        for (int m = 0; m < 4; ++m) { bf16* rowp = base + (size_t)(row0 + ai * HALF + m * 16) * ld + col0;
#pragma unroll
            for (int bj = 0; bj < 2; ++bj) { const f32x4 v0 = acc[ai][bj][m][0], v1 = acc[ai][bj][m][1]; v4u w;
                w.x = cvt_pk_bf16(actf<ACT>(v0[0]), actf<ACT>(v0[1])); w.y = cvt_pk_bf16(actf<ACT>(v0[2]), actf<ACT>(v0[3]));
                w.z = cvt_pk_bf16(actf<ACT>(v1[0]), actf<ACT>(v1[1])); w.w = cvt_pk_bf16(actf<ACT>(v1[2]), actf<ACT>(v1[3]));
                *(v4u*)(rowp + bj * HALF) = w; } }
}
struct EpiZ {
    static constexpr bool PERM = true; unsigned char* ws;
    __device__ __forceinline__ void operator()(const f32x4 (&acc)[2][2][4][2], const Unit& u, int wr, int wc, int fr, int fq) const {
        const int pn = u.pn, row0 = u.pm * BM + wr * 64 + fr, cl = wc * 32 + 8 * fq;
        const bool meta = (u.pm == MREAL / BM);
        if (pn < 4) { if (!meta) store_tile_bf16<1>(acc, (bf16*)(ws + WS_Q), D, row0, pn * BM + cl); }
        else if (pn == 4) store_tile_bf16<0>(acc, (bf16*)(ws + WS_K), KVW, row0, cl);
        else if (pn == 5) store_tile_bf16<0>(acc, (bf16*)(ws + WS_V), KVW, row0, cl);
        else if (pn < 10) store_tile_bf16<0>(acc, (bf16*)(ws + WS_XR), D, row0, (pn - 6) * BM + cl);
        else if (pn < 14) { if (!meta) store_tile_bf16<2>(acc, (bf16*)(ws + WS_GY), D, row0, (pn - 10) * BM + cl); }
        else if (pn < 18) { if (!meta) store_tile_bf16<3>(acc, (bf16*)(ws + WS_GA), D, row0, (pn - 14) * BM + cl); }
        else { if (!meta) store_tile_bf16<3>(acc, (bf16*)(ws + WS_GR), D, row0, (pn - 18) * BM + cl); }
    }
};
template <bool ADD> struct EpiGate {
    static constexpr bool PERM = true; const bf16* gate; const bf16* prev; bf16* out;
    __device__ __forceinline__ void operator()(const f32x4 (&acc)[2][2][4][2], const Unit& u, int wr, int wc, int fr, int fq) const {
        const int row0 = u.pm * BM + wr * 64 + fr, col0 = u.pn * BM + wc * 32 + 8 * fq;
#pragma unroll
        for (int ai = 0; ai < 2; ++ai)
#pragma unroll
            for (int m = 0; m < 4; ++m) { const size_t ro = (size_t)(row0 + ai * HALF + m * 16) * D + col0;
#pragma unroll
                for (int bj = 0; bj < 2; ++bj) { const f32x4 v0 = acc[ai][bj][m][0], v1 = acc[ai][bj][m][1];
                    const v4u g = *(const v4u*)(gate + ro + bj * HALF); v4u pv = (v4u){0u, 0u, 0u, 0u}; if (ADD) pv = *(const v4u*)(prev + ro + bj * HALF);
                    v4u w;
                    w.x = cvt_pk_bf16(bflo(pv.x) + bflo(g.x) * v0[0], bfhi(pv.x) + bfhi(g.x) * v0[1]); w.y = cvt_pk_bf16(bflo(pv.y) + bflo(g.y) * v0[2], bfhi(pv.y) + bfhi(g.y) * v0[3]);
                    w.z = cvt_pk_bf16(bflo(pv.z) + bflo(g.z) * v1[0], bfhi(pv.z) + bfhi(g.z) * v1[1]); w.w = cvt_pk_bf16(bflo(pv.w) + bflo(g.w) * v1[2], bfhi(pv.w) + bfhi(g.w) * v1[3]);
                    *(v4u*)(out + ro + bj * HALF) = w; } }
    }
};
struct EpiResF32 {
    static constexpr bool PERM = false; const float* res; float* out;
    __device__ __forceinline__ void operator()(const f32x4 (&acc)[2][2][4][2], const Unit& u, int wr, int wc, int fr, int fq) const {
        const int row0 = u.pm * BM + wr * 64 + fr, col0 = u.pn * BM + wc * 32 + 4 * fq;
#pragma unroll
        for (int ai = 0; ai < 2; ++ai)
#pragma unroll
            for (int m = 0; m < 4; ++m) { const size_t ro = (size_t)(row0 + ai * HALF + m * 16) * D + col0;
#pragma unroll
                for (int bj = 0; bj < 2; ++bj)
#pragma unroll
                    for (int n = 0; n < 2; ++n) { const size_t o = ro + bj * HALF + n * 16; *(f32x4*)(out + o) = *(const f32x4*)(res + o) + acc[ai][bj][m][n]; } }
    }
};
constexpr int MOE_TP = LDSCTL_OFF + 512, MOE_CNT = LDSCTL_OFF + 640, MOE_OFF = LDSCTL_OFF + 704, MOE_IDX = LDSCTL_OFF + 1024;
struct MoeSched {
    const LAS int* tp; const LAS int* cntp; const LAS int* offp; const LAS int* idx; int G, c, K; const char* A; const char* Bt; size_t bstride; bool gather;
    __device__ __forceinline__ bool next(int i, Unit& u) const {
        const int L = i * G + c, tile = L >> 2; if (tile >= tp[16]) return false;
        int e = 0;
#pragma unroll
        for (int k = 1; k < 16; ++k) e += (tile >= tp[k]) ? 1 : 0;
        u.e = e; u.pm = tile - tp[e]; u.pn = L & 3; u.cnt = cntp[e]; u.off = offp[e]; u.slot = i; return true;
    }
    __device__ __forceinline__ const char* a_base(const Unit& u) const { return gather ? A : A + (size_t)(u.off + u.pm * BM) * K * 2; }
    __device__ __forceinline__ const char* b_base(const Unit& u) const { return Bt + (size_t)u.e * bstride + (size_t)u.pn * BM * K * 2; }
    __device__ __forceinline__ void a_offsets(const Unit& u, const int (&RA)[2], const int (&CA)[2], unsigned (&v)[2][2]) const {
#pragma unroll
        for (int h = 0; h < 2; ++h)
#pragma unroll
            for (int i = 0; i < 2; ++i) { const int row = gather ? idx[u.slot * 256 + h * HALF + RA[i]] : h * HALF + RA[i]; v[h][i] = (unsigned)(row * K + CA[i]) * 2u; } }
};
struct EpiMoe1 {
    static constexpr bool PERM = true; bf16* hdn;
    __device__ __forceinline__ void operator()(const f32x4 (&acc)[2][2][4][2], const Unit& u, int wr, int wc, int fr, int fq) const {
        const int row0 = u.off + u.pm * BM + wr * 64 + fr, col0 = u.pn * HALF + wc * 32 + 8 * fq;
#pragma unroll
        for (int ai = 0; ai < 2; ++ai)
#pragma unroll
            for (int m = 0; m < 4; ++m) { float h[8];
#pragma unroll
                for (int n = 0; n < 2; ++n)
#pragma unroll
                    for (int i = 0; i < 4; ++i) { const float g = acc[ai][0][m][n][i], up = acc[ai][1][m][n][i]; h[4 * n + i] = g * __builtin_amdgcn_rcpf(1.f + __builtin_amdgcn_exp2f(-LOG2E * g)) * up; }
                v4u w; w.x = cvt_pk_bf16(h[0], h[1]); w.y = cvt_pk_bf16(h[2], h[3]); w.z = cvt_pk_bf16(h[4], h[5]); w.w = cvt_pk_bf16(h[6], h[7]);
                *(v4u*)(hdn + (size_t)(row0 + ai * HALF + m * 16) * FF + col0) = w; }
    }
};
struct EpiMoe2 {
    static constexpr bool PERM = true; const unsigned* list; const float* wlist; bf16* y;
    __device__ __forceinline__ void operator()(const f32x4 (&acc)[2][2][4][2], const Unit& u, int wr, int wc, int fr, int fq) const {
        const int r0 = u.pm * BM + wr * 64 + fr, col0 = u.pn * BM + wc * 32 + 8 * fq;
#pragma unroll
        for (int ai = 0; ai < 2; ++ai)
#pragma unroll
            for (int m = 0; m < 4; ++m) { const int ii = r0 + ai * HALF + m * 16;
                if (ii < u.cnt) { const unsigned le = list[u.e * MREAL + ii]; const float w = wlist[u.e * MREAL + ii];
                    bf16* rowp = y + ((size_t)(le >> 14) * MREAL + (le & 0x3fffu)) * D + col0;
#pragma unroll
                    for (int bj = 0; bj < 2; ++bj) { const f32x4 v0 = acc[ai][bj][m][0] * w, v1 = acc[ai][bj][m][1] * w; v4u o;
                        o.x = cvt_pk_bf16(v0[0], v0[1]); o.y = cvt_pk_bf16(v0[2], v0[3]); o.z = cvt_pk_bf16(v1[0], v1[1]); o.w = cvt_pk_bf16(v1[2], v1[3]);
                        *(v4u*)(rowp + bj * HALF) = o; } } }
    }
};
}

__device__ __forceinline__ void p1_fast(Frame& F, const Args& A) {
    pg8::StaticOrder S; S.init((const bf16*)(F.ws + WS_XN), (const bf16*)(F.ws + WS_WIN), MPAD, INW, D, F.G, (int)blockIdx.x);
    pg8::EpiZ E{F.ws};
    pg8::gemm_phase<pg8::EpiZ, pg8::StaticOrder, true>(F.lds, D, S, E);
}
__device__ __forceinline__ void merge_fast(Frame& F, const Args& A) {
    { pg8::StaticOrder S; S.init((const bf16*)(F.ws + WS_Q), (const bf16*)(F.ws + WS_WATT), MREAL, D, D, F.G, (int)blockIdx.x);
      pg8::EpiGate<false> E{(const bf16*)(F.ws + WS_GA), nullptr, (bf16*)(F.ws + WS_XR)};
      pg8::gemm_phase<pg8::EpiGate<false>, pg8::StaticOrder, false>(F.lds, D, S, E); }
    VM_WAIT(); __builtin_amdgcn_fence(__ATOMIC_ACQUIRE, "agent"); VM_WAIT(); __syncthreads();
    { pg8::StaticOrder S; S.init((const bf16*)(F.ws + WS_GY), (const bf16*)(F.ws + WS_WREC), MREAL, D, D, F.G, (int)blockIdx.x);
      pg8::EpiGate<true> E{(const bf16*)(F.ws + WS_GR), (const bf16*)(F.ws + WS_XR), (bf16*)(F.ws + WS_XR)};
      pg8::gemm_phase<pg8::EpiGate<true>, pg8::StaticOrder, false>(F.lds, D, S, E); }
}
__device__ __forceinline__ void wout_fast(Frame& F, const Args& A) {
    pg8::StaticOrder S; S.init((const bf16*)(F.ws + WS_XR), (const bf16*)(F.ws + WS_WOUT), MREAL, D, D, F.G, (int)blockIdx.x);
    pg8::EpiResF32 E{A.in[I_X], F.out};
    pg8::gemm_phase<pg8::EpiResF32, pg8::StaticOrder, false>(F.lds, D, S, E);
}
__device__ __forceinline__ void moe_tables(Frame& F) {
    LAS int* tp = (LAS int*)(F.lds + pg8::MOE_TP); LAS int* cp = (LAS int*)(F.lds + pg8::MOE_CNT); LAS int* op = (LAS int*)(F.lds + pg8::MOE_OFF);
    if (F.tid == 0) { int t = 0, o = 0;
        for (int e = 0; e < NEXP; ++e) { const int cnt = (int)__hip_atomic_load(F.ctl + CW_CNT + 64 * e, RLX_AGENT); tp[e] = t; cp[e] = cnt; op[e] = o; t += (cnt + 255) >> 8; o += (cnt + 255) & ~255; }
        tp[16] = t; }
    __syncthreads();
}
__device__ __forceinline__ void moe1_fast(Frame& F, const Args& A) {
    moe_tables(F);
    pg8::MoeSched S{(const LAS int*)(F.lds + pg8::MOE_TP), (const LAS int*)(F.lds + pg8::MOE_CNT), (const LAS int*)(F.lds + pg8::MOE_OFF), (const LAS int*)(F.lds + pg8::MOE_IDX),
                    F.G, (int)blockIdx.x, D, (const char*)(F.ws + WS_Q), (const char*)(F.ws + WS_WGU), (size_t)1024 * 1024 * 2, true};
    { const unsigned* LIST = (const unsigned*)(F.ws + WS_LIST); LAS int* idx = (LAS int*)(F.lds + pg8::MOE_IDX); pg8::Unit u;
      for (int i = 0; i < 8 && S.next(i, u); ++i) if (F.tid < 256) { const int ii = u.pm * 256 + F.tid; idx[i * 256 + F.tid] = (int)(LIST[u.e * MREAL + (ii < u.cnt ? ii : 0)] & 0x3fffu); }
      __syncthreads(); }
    pg8::EpiMoe1 E{(bf16*)(F.ws + WS_XR)};
    pg8::gemm_phase<pg8::EpiMoe1, pg8::MoeSched, true>(F.lds, D, S, E);
}
__device__ __forceinline__ void moe2_fast(Frame& F, const Args& A) {
    moe_tables(F);
    pg8::MoeSched S{(const LAS int*)(F.lds + pg8::MOE_TP), (const LAS int*)(F.lds + pg8::MOE_CNT), (const LAS int*)(F.lds + pg8::MOE_OFF), (const LAS int*)(F.lds + pg8::MOE_IDX),
                    F.G, (int)blockIdx.x, FF, (const char*)(F.ws + WS_XR), (const char*)(F.ws + WS_WD), (size_t)1024 * 512 * 2, false};
    pg8::EpiMoe2 E{(const unsigned*)(F.ws + WS_LIST), (const float*)(F.ws + WS_WLIST), (bf16*)(F.ws + WS_GA)};
    pg8::gemm_phase<pg8::EpiMoe2, pg8::MoeSched, true>(F.lds, FF, S, E);
}


namespace scan {
constexpr int XC_OFF = 0, OUT_OFF = 65536, NCH = SEQ / 256, NSUM = NCH + 1;
typedef __attribute__((address_space(3))) const unsigned char* lcp;
template <int CTRL> __device__ __forceinline__ float dppf(float old, float v) {
    return __builtin_bit_cast(float, __builtin_amdgcn_update_dpp(__builtin_bit_cast(int, old), __builtin_bit_cast(int, v), CTRL, 0xf, 0xf, false)); }
template <int PAT> __device__ __forceinline__ float swz(float v) { return __builtin_bit_cast(float, __builtin_amdgcn_ds_swizzle(__builtin_bit_cast(int, v), PAT)); }
template <int DIR> __device__ __forceinline__ f32x4 scan_tile(lcp xc, int jt, const bf16x8 (&wf)[2][4], const f32x4 (&bias)[2], const f32x4 c2, f32x4& carry, f32x4& lsum, int w, int fr, int fq) {
    lcp rp = xc + (16 * jt + fr) * 256;
    f32x4 ar = bias[0], ai = bias[1];
#pragma unroll
    for (int ks = 0; ks < 4; ++ks) { const bf16x8 bfr = *(const LAS bf16x8*)(rp + (((4 * ks + fq) ^ fr) << 4));
        ar = __builtin_amdgcn_mfma_f32_16x16x32_bf16(wf[0][ks], bfr, ar, 0, 0, 0);
        ai = __builtin_amdgcn_mfma_f32_16x16x32_bf16(wf[1][ks], bfr, ai, 0, 0, 0); }
    const v2u xw = *(const LAS v2u*)(rp + (((2 * w + (fq >> 1)) ^ fr) << 4) + (fq & 1) * 8);
    const float xv[4] = {bflo(xw.x), bfhi(xw.x), bflo(xw.y), bfhi(xw.y)};
    f32x4 P, H;
#pragma unroll
    for (int r = 0; r < 4; ++r) {
        const float rg = __builtin_amdgcn_rcpf(1.f + __builtin_amdgcn_exp2f(ar[r])), ig = __builtin_amdgcn_rcpf(1.f + __builtin_amdgcn_exp2f(ai[r]));
        const float la = c2[r] * rg, a = __builtin_amdgcn_exp2f(la);
        P[r] = a; H[r] = __builtin_amdgcn_sqrtf(fmaf(-a, a, 1.f)) * (ig * xv[r]); lsum[r] += la; }
#define SCAN_STEP(dd) do { _Pragma("unroll") for (int r = 0; r < 4; ++r) { \
        const float Hs = dppf<(DIR ? 0x100 : 0x110) + dd>(0.f, H[r]), Ps = dppf<(DIR ? 0x100 : 0x110) + dd>(1.f, P[r]); H[r] = fmaf(P[r], Hs, H[r]); P[r] *= Ps; } } while (0)
    SCAN_STEP(1); SCAN_STEP(2); SCAN_STEP(4); SCAN_STEP(8);
#undef SCAN_STEP
    f32x4 h;
#pragma unroll
    for (int r = 0; r < 4; ++r) { h[r] = fmaf(P[r], carry[r], H[r]); carry[r] = swz<DIR ? 0x010 : 0x1F0>(h[r]); }
    __builtin_amdgcn_sched_barrier(0);
    return h;
}
template <int DIR> __device__ __forceinline__ void scan_consts(Frame& F, const Args& A, int n, int w, int fr, int fq, bf16x8 (&wf)[2][4], f32x4 (&bias)[2], f32x4& c2) {
    const bf16* WL = (const bf16*)(F.ws + WS_WLRU) + (size_t)n * 512 * 128;
#pragma unroll
    for (int g = 0; g < 2; ++g)
#pragma unroll
        for (int ks = 0; ks < 4; ++ks) wf[g][ks] = *(const bf16x8*)(WL + (size_t)((DIR * 2 + g) * 128 + 16 * w + fr) * 128 + 32 * ks + 8 * fq);
    const int ch0 = 128 * n + 16 * w + 4 * fq;
    bias[0] = *(const f32x4*)(A.in[I_LBA] + DIR * D + ch0) * (-LOG2E); bias[1] = *(const f32x4*)(A.in[I_LBX] + DIR * D + ch0) * (-LOG2E);
    const f32x4 lam = *(const f32x4*)(A.in[I_LAM] + DIR * D + ch0);
#pragma unroll
    for (int r = 0; r < 4; ++r) c2[r] = -8.f * LOG2E * log1pf(__expf(-lam[r]));
}
template <bool FINAL> __device__ __forceinline__ void scan_unit(Frame& F, const Args& A, int b, int n, int c  ) {
    const int tid = F.tid, lane = F.lane, w = F.wave, fr = lane & 15, fq = lane >> 4;
    const int NT = c < 0 ? 1 : 16, t0 = c < 0 ? 0 : NMETA + 256 * c;
    const bf16* XR = (const bf16*)(F.ws + WS_XR);
    LAS unsigned char* lds = F.lds;
    {
        const int q = tid & 15, gc = 128 * n + 8 * q;
        float cw[4][8], cbv[8];
#pragma unroll
        for (int i = 0; i < 8; ++i) { cbv[i] = A.in[I_CONVB][gc + i];
#pragma unroll
            for (int j = 0; j < 4; ++j) cw[j][i] = A.in[I_CONVW][j * D + gc + i]; }
        for (int tt = tid >> 4; tt < 16 * NT; tt += 32) { const int t = t0 + tt;
            float a8[8];
#pragma unroll
            for (int i = 0; i < 8; ++i) a8[i] = cbv[i];
#pragma unroll
            for (int j = 0; j < 4; ++j) { const int ts = t - 2 + j;
                if (ts >= 0 && ts < TLEN) { const v4u x = *(const v4u*)(XR + (size_t)trow(b, ts) * D + gc);
                    a8[0] += cw[j][0] * bflo(x.x); a8[1] += cw[j][1] * bfhi(x.x); a8[2] += cw[j][2] * bflo(x.y); a8[3] += cw[j][3] * bfhi(x.y);
                    a8[4] += cw[j][4] * bflo(x.z); a8[5] += cw[j][5] * bfhi(x.z); a8[6] += cw[j][6] * bflo(x.w); a8[7] += cw[j][7] * bfhi(x.w); } }
            v4u o; o.x = pg8::cvt_pk_bf16(a8[0], a8[1]); o.y = pg8::cvt_pk_bf16(a8[2], a8[3]); o.z = pg8::cvt_pk_bf16(a8[4], a8[5]); o.w = pg8::cvt_pk_bf16(a8[6], a8[7]);
            *(LAS v4u*)(lds + XC_OFF + tt * 256 + ((q ^ (tt & 15)) << 4)) = o; }
    }
    __syncthreads();
    const int ch0 = 128 * n + 16 * w + 4 * fq;
    float* SUMP = (float*)(F.ws + WS_SUM); float* SUMH = SUMP + 2 * 2 * NSUM * D;
    lcp xc = (lcp)(lds + XC_OFF);
    bf16x8 wf[2][4]; f32x4 bias[2], c2;
    if constexpr (!FINAL) {
        {   f32x4 cf = (f32x4){0.f, 0.f, 0.f, 0.f}, lf = cf;
            scan_consts<0>(F, A, n, w, fr, fq, wf, bias, c2);
            for (int j = 0; j < NT; ++j) (void)scan_tile<0>(xc, j, wf, bias, c2, cf, lf, w, fr, fq);
#pragma unroll
            for (int r = 0; r < 4; ++r) {
#pragma unroll
                for (int o = 1; o < 16; o <<= 1) lf[r] += __shfl_xor(lf[r], o);
                lf[r] = __builtin_amdgcn_exp2f(lf[r]); }
            if (fr == 0) { const size_t o0 = ((size_t)(0 * 2 + b) * NSUM + (c + 1)) * D + ch0; *(f32x4*)(SUMP + o0) = lf; *(f32x4*)(SUMH + o0) = cf; } }
        if (c >= 0) { f32x4 cb = (f32x4){0.f, 0.f, 0.f, 0.f}, lb = cb;
            scan_consts<1>(F, A, n, w, fr, fq, wf, bias, c2);
            for (int j = NT - 1; j >= 0; --j) (void)scan_tile<1>(xc, j, wf, bias, c2, cb, lb, w, fr, fq);
#pragma unroll
            for (int r = 0; r < 4; ++r) {
#pragma unroll
                for (int o = 1; o < 16; o <<= 1) lb[r] += __shfl_xor(lb[r], o);
                lb[r] = __builtin_amdgcn_exp2f(lb[r]); }
            if (fr == 0) { const size_t o1 = ((size_t)(1 * 2 + b) * NSUM + (c + 1)) * D + ch0; *(f32x4*)(SUMP + o1) = lb; *(f32x4*)(SUMH + o1) = cb; } }
        __syncthreads();
    } else {
        f32x4 cf = (f32x4){0.f, 0.f, 0.f, 0.f}, cb = cf, ls = cf;
        for (int j = 0; j <= c; ++j) { const size_t o = ((size_t)(0 * 2 + b) * NSUM + j) * D + ch0; const f32x4 p = *(const f32x4*)(SUMP + o), h = *(const f32x4*)(SUMH + o); cf = p * cf + h; }
        for (int j = NCH; j > c + 1; --j) { const size_t o = ((size_t)(1 * 2 + b) * NSUM + j) * D + ch0; const f32x4 p = *(const f32x4*)(SUMP + o), h = *(const f32x4*)(SUMH + o); cb = p * cb + h; }
        f32x4 hfb[16];
        scan_consts<0>(F, A, n, w, fr, fq, wf, bias, c2);
#pragma unroll
        for (int j = 0; j < 16; ++j) hfb[j] = scan_tile<0>(xc, j, wf, bias, c2, cf, ls, w, fr, fq);
        scan_consts<1>(F, A, n, w, fr, fq, wf, bias, c2);
#pragma unroll
        for (int j = 15; j >= 0; --j) { const f32x4 v_ = hfb[j] + scan_tile<1>(xc, j, wf, bias, c2, cb, ls, w, fr, fq);
            v2u o_; o_.x = pg8::cvt_pk_bf16(v_[0], v_[1]); o_.y = pg8::cvt_pk_bf16(v_[2], v_[3]);
            *(LAS v2u*)(lds + OUT_OFF + (16 * j + fr) * 256 + (((2 * w + (fq >> 1)) ^ fr) << 4) + (fq & 1) * 8) = o_; }
        __syncthreads();
        bf16* GY = (bf16*)(F.ws + WS_GY);
        const int q = tid & 15;
        for (int tt = tid >> 4; tt < 256; tt += 32) {
            const v4u hv = *(const LAS v4u*)(lds + OUT_OFF + tt * 256 + ((q ^ (tt & 15)) << 4));
            bf16* gp = GY + (size_t)(b * SEQ + 256 * c + tt) * D + 128 * n + 8 * q; const v4u g = *(const v4u*)gp; v4u o;
            o.x = pg8::cvt_pk_bf16(bflo(hv.x) * bflo(g.x), bfhi(hv.x) * bfhi(g.x)); o.y = pg8::cvt_pk_bf16(bflo(hv.y) * bflo(g.y), bfhi(hv.y) * bfhi(g.y));
            o.z = pg8::cvt_pk_bf16(bflo(hv.z) * bflo(g.z), bfhi(hv.z) * bfhi(g.z)); o.w = pg8::cvt_pk_bf16(bflo(hv.w) * bflo(g.w), bfhi(hv.w) * bfhi(g.w));
            *(v4u*)gp = o; }
        __syncthreads();
    }
}
template <bool FINAL> __device__ __forceinline__ void scan_phase(Frame& F, const Args& A) {
    constexpr int PER = FINAL ? NCH : NSUM, NU = BATCH * 8 * PER;
    for (int it = F.vcu; it < NU; it += F.G) { const int b = it / (8 * PER), r = it % (8 * PER), ci = r / 8, n = r % 8; scan_unit<FINAL>(F, A, b, n, FINAL ? ci : ci - 1); }
}
}


namespace attn {
typedef float f32x16 __attribute__((ext_vector_type(16)));
typedef short s16x4 __attribute__((ext_vector_type(4)));
typedef __attribute__((address_space(3))) const char* lds_cptr;
constexpr int SHM = 16384, V_OFF = 0, K_OFF = 2 * SHM, WSC_OFF = 4 * SHM;
#define KSWZ(row, colB) ((row) * 256 + ((colB) ^ (((row) & 7) << 4)))
__device__ __forceinline__ int v_st(int k, int c) { const int kk = (k & ~0xC) | ((k & 4) << 1) | ((k & 8) >> 1); return ((kk >> 3) * 4 + (c >> 5)) * 512 + ((kk & 7) * 32 + (c & 31)) * 2; }
__device__ __forceinline__ int v_rd_base(int lane) { return ((lane & 3) << 3) | (((lane >> 2) & 3) << 6) | (((lane >> 4) & 1) << 5) | (((lane >> 5) & 1) << 8); }
constexpr int v_rd_off(int d0, int ks, int half) { return d0 * 512 + ks * 4096 + half * 2048; }
__device__ __forceinline__ int crow(int r, int hi) { return (r & 3) + 8 * (r >> 2) + 4 * hi; }
__device__ __forceinline__ s16x4 vtr(lds_cptr p) { typedef short v4i16_t __attribute__((ext_vector_type(4))); return __builtin_bit_cast(s16x4, __builtin_amdgcn_ds_read_tr16_b64_v4i16((__attribute__((address_space(3))) v4i16_t*)p)); }
template <int KB> __device__ __forceinline__ void qkt(f32x16& p0, f32x16& p1, lds_cptr K_lds, int r32, int hi, const bf16x8 (&qr)[8], bool second) {
    p0 = f32x16{}; p1 = f32x16{};
    lds_cptr kb[4];
#pragma unroll
    for (int dd = 0; dd < 4; ++dd) kb[dd] = K_lds + KB * SHM + KSWZ(r32, (dd * 16 + hi * 8) * 2);
#pragma unroll
    for (int d0 = 0; d0 < 8; ++d0) { lds_cptr a = kb[d0 & 3] + (d0 >> 2) * 128;
        const bf16x8 b0 = *(const LAS bf16x8*)a;
        p0 = __builtin_amdgcn_mfma_f32_32x32x16_bf16(b0, qr[d0], p0, 0, 0, 0);
        if (second) { const bf16x8 b1 = *(const LAS bf16x8*)(a + 32 * 256); p1 = __builtin_amdgcn_mfma_f32_32x32x16_bf16(b1, qr[d0], p1, 0, 0, 0); } }
}
template <int VB> __device__ __forceinline__ void pv_tile(f32x16 (&o)[4], int vb0, bf16x8 pa0, bf16x8 pa1, bf16x8 pa2, bf16x8 pa3, bool full) {
#define TRRD(dst, off) asm volatile("ds_read_b64_tr_b16 %0, %1 offset:%2" : "=&v"(dst) : "v"(vb0), "i"(off) : "memory")
#define PKV(l_, h_) (bf16x8){l_[0], l_[1], l_[2], l_[3], h_[0], h_[1], h_[2], h_[3]}
#define PV_D0(d0) do { s16x4 l0, l1, l2, l3, h0, h1, h2, h3; constexpr int b_ = VB * SHM + v_rd_off(d0, 0, 0); \
        TRRD(l0, b_); TRRD(h0, b_ + 2048); \
        if (full) { TRRD(l1, b_ + 4096); TRRD(h1, b_ + 6144); TRRD(l2, b_ + 8192); TRRD(h2, b_ + 10240); TRRD(l3, b_ + 12288); TRRD(h3, b_ + 14336); } \
        asm volatile("s_waitcnt lgkmcnt(0)" ::: "memory"); __builtin_amdgcn_sched_barrier(0); \
        o[d0] = __builtin_amdgcn_mfma_f32_32x32x16_bf16(pa0, PKV(l0, h0), o[d0], 0, 0, 0); \
        if (full) { o[d0] = __builtin_amdgcn_mfma_f32_32x32x16_bf16(pa1, PKV(l1, h1), o[d0], 0, 0, 0); \
                    o[d0] = __builtin_amdgcn_mfma_f32_32x32x16_bf16(pa2, PKV(l2, h2), o[d0], 0, 0, 0); \
                    o[d0] = __builtin_amdgcn_mfma_f32_32x32x16_bf16(pa3, PKV(l3, h3), o[d0], 0, 0, 0); } } while (0)
    PV_D0(0); PV_D0(1); PV_D0(2); PV_D0(3);
#undef PV_D0
#undef PKV
#undef TRRD
}
struct St { bf16x8 k0, k1, v0, v1; };
__device__ __forceinline__ void attn_unit(Frame& F, const float* sinkp, int b, int kv, int qb) {
    const int tid = F.tid, lane = F.lane, w = F.wave, r32 = lane & 31, hi = lane >> 5;
    const int h = 4 * kv + (w >> 1), s0 = 64 * qb, qlo = s0 + 32 * (w & 1), qpos = qlo + r32;
    bf16* Q = (bf16*)(F.ws + WS_Q); const bf16* Kb = (const bf16*)(F.ws + WS_K); const bf16* Vb = (const bf16*)(F.ws + WS_V);
    LAS unsigned char* lds = F.lds;
    lds_cptr K_lds = (lds_cptr)(lds + K_OFF); const int vp = (int)(uintptr_t)(lds + V_OFF) + v_rd_base(lane);
    LAS float* wsc = (LAS float*)(lds + WSC_OFF) + w * 64;
    const float slope2 = __builtin_amdgcn_exp2f(-(float)(h + 1)) * LOG2E;
    const int j_lo = s0 >= 128 ? 0 : (128 - s0) / 64, j_hi = (SEQ - s0 + 128) / 64 < 5 ? (SEQ - s0 + 128) / 64 : 5, NT = 1 + j_hi - j_lo;
    const int sr = tid >> 4, sc = (tid & 15) * 8, kws = KSWZ(sr, sc * 2), vst0 = v_st(sr, sc), vst1 = v_st(32 + sr, sc);
    const size_t kvcol = (size_t)kv * HD + sc;
    St st;
#define ST_LOAD(t) do { size_t ra_, rb_; if ((t) == 0) { ra_ = (size_t)(MREAL + (sr < 16 ? sr : 15)); rb_ = (size_t)(MREAL + 15); } \
        else { const int kb_ = s0 - 128 + 64 * (j_lo + (t) - 1); ra_ = (size_t)(b * SEQ + kb_ + sr); rb_ = ra_ + 32; } \
        st.k0 = *(const bf16x8*)(Kb + ra_ * KVW + kvcol); st.k1 = *(const bf16x8*)(Kb + rb_ * KVW + kvcol); st.v0 = *(const bf16x8*)(Vb + ra_ * KVW + kvcol); st.v1 = *(const bf16x8*)(Vb + rb_ * KVW + kvcol); } while (0)
#define ST_WRITE(bf) do { *(LAS bf16x8*)(lds + K_OFF + (bf) * SHM + kws) = st.k0; *(LAS bf16x8*)(lds + K_OFF + (bf) * SHM + kws + 32 * 256) = st.k1; \
        *(LAS bf16x8*)(lds + V_OFF + (bf) * SHM + vst0) = st.v0; *(LAS bf16x8*)(lds + V_OFF + (bf) * SHM + vst1) = st.v1; } while (0)
    ST_LOAD(0);
    bf16x8 qr[8];
    { const bf16* qp = Q + (size_t)(b * SEQ + qpos) * D + h * HD + hi * 8;
#pragma unroll
      for (int d0 = 0; d0 < 8; ++d0) qr[d0] = *(const bf16x8*)(qp + d0 * 16); }
    float m_reg = sinkp[h] * LOG2E, l_reg = 1.f;
    f32x16 o[4] = {};
    ST_WRITE(0);
    __syncthreads();
    for (int t = 0; t < NT; ++t) {
        f32x16 p0, p1;
        const bool band = t > 0;
        if (t & 1) qkt<1>(p0, p1, K_lds, r32, hi, qr, band); else qkt<0>(p0, p1, K_lds, r32, hi, qr, band);
        const float NEG = -__builtin_inff();
        if (!band) {
#pragma unroll
            for (int r = 8; r < 16; ++r) p0[r] = NEG;
#pragma unroll
            for (int r = 0; r < 16; ++r) p1[r] = NEG;
        } else {
            const int kb = s0 - 128 + 64 * (j_lo + t - 1);
            const float dqf = (float)(kb + 4 * hi - qpos);
            const bool need_mask = (kb + 63 > qlo + 128) || (kb < qlo + 31 - 128);
#pragma unroll
            for (int r = 0; r < 16; ++r) { const float c = (float)((r & 3) + 8 * (r >> 2)); const float d0 = fabsf(dqf + c), d1 = fabsf(dqf + c + 32.f);
                p0[r] = fmaf(-slope2, d0, p0[r]); p1[r] = fmaf(-slope2, d1, p1[r]);
                if (need_mask) { if (d0 > 128.f) p0[r] = NEG; if (d1 > 128.f) p1[r] = NEG; } }
        }
        float pmax = p0[0];
#pragma unroll
        for (int r = 1; r < 16; ++r) pmax = fmaxf(pmax, p0[r]);
#pragma unroll
        for (int r = 0; r < 16; ++r) pmax = fmaxf(pmax, p1[r]);
        { auto rr = __builtin_amdgcn_permlane32_swap(__float_as_uint(pmax), __float_as_uint(pmax), false, false); pmax = fmaxf(__uint_as_float(rr[0]), __uint_as_float(rr[1])); }
        const float mn = fmaxf(m_reg, pmax), alpha = __builtin_amdgcn_exp2f(m_reg - mn); m_reg = mn;
        float ps = 0.f;
#pragma unroll
        for (int r = 0; r < 16; ++r) { p0[r] = __builtin_amdgcn_exp2f(p0[r] - mn); p1[r] = __builtin_amdgcn_exp2f(p1[r] - mn); ps += p0[r] + p1[r]; }
        { auto rr = __builtin_amdgcn_permlane32_swap(__float_as_uint(ps), __float_as_uint(ps), false, false); ps = __uint_as_float(rr[0]) + __uint_as_float(rr[1]); }
        l_reg = l_reg * alpha + ps;
        bf16x8 pa0, pa1, pa2, pa3;
#define PK4(P, B_, OUT) do { const unsigned a0 = pg8::cvt_pk_bf16(P[B_ + 0], P[B_ + 1]), a1 = pg8::cvt_pk_bf16(P[B_ + 2], P[B_ + 3]), b0 = pg8::cvt_pk_bf16(P[B_ + 4], P[B_ + 5]), b1 = pg8::cvt_pk_bf16(P[B_ + 6], P[B_ + 7]); \
        auto r0 = __builtin_amdgcn_permlane32_swap(a0, b0, false, false); auto r1 = __builtin_amdgcn_permlane32_swap(a1, b1, false, false); \
        v4u w_ = {r0[0], r1[0], r0[1], r1[1]}; OUT = __builtin_bit_cast(bf16x8, w_); } while (0)
        PK4(p0, 0, pa0); PK4(p0, 8, pa1); PK4(p1, 0, pa2); PK4(p1, 8, pa3);
#undef PK4
        if (__any(alpha < 1.f)) { if (hi == 0) wsc[r32] = alpha; LDS_WAIT();
#pragma unroll
            for (int d_ = 0; d_ < 4; ++d_)
#pragma unroll
                for (int r = 0; r < 16; ++r) o[d_][r] *= wsc[crow(r, hi)];
            LDS_WAIT(); }
        if (t + 1 < NT) ST_LOAD(t + 1);
        __builtin_amdgcn_sched_barrier(0);
        if (t & 1) pv_tile<1>(o, vp, pa0, pa1, pa2, pa3, band); else pv_tile<0>(o, vp, pa0, pa1, pa2, pa3, band);
        if (t + 1 < NT) { if ((t + 1) & 1) ST_WRITE(1); else ST_WRITE(0); }
        __syncthreads();
    }
#undef ST_LOAD
#undef ST_WRITE
    { int l2 = lane; asm volatile("" : "+v"(l2)); const int e32 = l2 & 31, ehi = l2 >> 5;
      if (ehi == 0) wsc[32 + e32] = l_reg; LDS_WAIT();
      LAS bf16* stg = (LAS bf16*)(lds + w * 8192);
#pragma unroll
      for (int r = 0; r < 16; ++r) { const int orow = (r & 3) + 8 * (r >> 2); const float rl = __builtin_amdgcn_rcpf(wsc[32 + orow + 4 * ehi]);
#pragma unroll
          for (int d0 = 0; d0 < 4; ++d0) stg[(orow + 4 * ehi) * 128 + d0 * 32 + e32] = (bf16)(pg8::cvt_pk_bf16(o[d0][r] * rl, 0.f) & 0xffffu); }
      LDS_WAIT();
      bf16* Ow = Q + (size_t)(b * SEQ + qlo) * D + h * HD;
      const unsigned eoff = (unsigned)((l2 >> 4) * D + (l2 & 15) * 8);
#pragma unroll
      for (int i = 0; i < 8; ++i) { const v4u v = *(const LAS v4u*)(stg + (i * 4 + (l2 >> 4)) * 128 + (l2 & 15) * 8); *(v4u*)(Ow + eoff + i * 4 * D) = v; }
      LDS_WAIT(); }
    __syncthreads();
}
__device__ __forceinline__ void attn_phase(Frame& F, const Args& A) {
    for (int it = F.vcu; it < BATCH * NKV * (SEQ / 64); it += F.G) { const int bk = it / (SEQ / 64), qb = it % (SEQ / 64); attn_unit(F, A.in[I_SINK], bk >> 1, bk & 1, qb); }
}
#undef KSWZ
}

constexpr int NPHASE = 10;
#ifndef FAST_ATTN
#define FAST_ATTN 1
#endif
#ifndef FAST_SCAN
#define FAST_SCAN 1
#endif
#ifndef P1_LO
#define P1_LO 112
#define P1_HI 176
#endif
#ifndef FAST_P1
#define FAST_P1 1
#endif
#ifndef FAST_MERGE
#define FAST_MERGE 1
#endif
#ifndef FAST_WOUT
#define FAST_WOUT 1
#endif
#ifndef FAST_MOE
#define FAST_MOE 1
#endif
__global__ void __launch_bounds__(NTHREADS, 2) mega_fwd(Args args) {
    extern __shared__ __attribute__((aligned(16))) unsigned char lds[];
    Frame F;
    F.lds = (LAS unsigned char*)lds;
    F.MISC = (volatile LAS unsigned*)(F.lds + MISC_OFF);
    F.tid = threadIdx.x; F.lane = F.tid & 63; F.wave = __builtin_amdgcn_readfirstlane(F.tid >> 6);
    F.G = gridDim.x; { const int bx = blockIdx.x; F.vcu = (F.G % 8 == 0) ? (bx % 8) * (F.G / 8) + bx / 8 : bx; }
    F.ws = args.ws; F.out = args.out; F.ctl = (gu32*)(args.ws + WS_CTL);
    for (int u = F.tid; u < (LDS_BYTES - LDSCTL_OFF) / 4; u += NTHREADS) ((LAS unsigned*)(F.lds + LDSCTL_OFF))[u] = 0u;
    __syncthreads();
    XcdBarrier bar; bar.bar = (unsigned*)(F.ctl + CW_BAR); bar.x = 0; bar.st = nullptr;
    if (args.use_bar) bar = xcd_barrier_post((unsigned*)(F.ctl + CW_BAR), F.MISC + 8);
    const int lo = args.ph_lo, hi = args.ph_hi;
#define IN(k) (lo <= (k) && (k) < hi && (refresh(F), true))
#define SEAM(k) do { if (lo <= (k) && (k) + 1 < hi) xcd_barrier(bar); } while (0)
    if (IN(0)) { p0_prologue<0>(F, args); } SEAM(0);
    if (IN(1)) { if (FAST_P1) p1_fast(F, args); else p1_simple(F, args); } SEAM(1);
    if (IN(2)) { p0_prologue<1>(F, args); __syncthreads(); if (FAST_SCAN) scan::scan_phase<false>(F, args); else scan_simple(F, args); if (FAST_ATTN) attn::attn_phase(F, args); else attn_simple(F, args); } SEAM(2);
    if (IN(3)) { if (FAST_SCAN) scan::scan_phase<true>(F, args); } SEAM(3);
    if (IN(4)) { if (FAST_MERGE) merge_fast(F, args); else merge_simple(F, args); } SEAM(4);
    if (IN(5)) { if (FAST_WOUT) wout_fast(F, args); else wout_simple(F, args); } SEAM(5);
    if (IN(6)) { route_simple(F, args); } SEAM(6);
    if (IN(7)) { if (FAST_MOE) moe1_fast(F, args); else moe1_simple(F, args); } SEAM(7);
    if (IN(8)) { if (FAST_MOE) moe2_fast(F, args); else moe2_simple(F, args); } SEAM(8);
    if (IN(9)) { final_rows(F, args); }
#undef IN
#undef SEAM
}

#ifndef MK_N_LAUNCHES
#define MK_N_LAUNCHES 1
#endif
extern "C" void kernel_launch(void* const* d_in, const int* in_sizes, int n_in, void* d_out, int out_size, void* d_ws, size_t ws_size, hipStream_t stream) {
    static int grid = 0;
    if (grid == 0) {
        if (n_in != 24 || in_sizes[0] != MREAL * D || out_size != MREAL * D || ws_size < WS_END) {
            fprintf(stderr, "kernel_launch: unexpected shapes: n_in %d in0 %d out %d ws %zu (need %zu)\n", n_in, n_in > 0 ? in_sizes[0] : -1, out_size, ws_size, (size_t)WS_END); grid = -1; return; }
        int dev = 0, cus = 0, per_cu = 0;
        if (hipGetDevice(&dev) != hipSuccess || hipDeviceGetAttribute(&cus, hipDeviceAttributeMultiprocessorCount, dev) != hipSuccess) { grid = -1; return; }
        if (hipFuncSetAttribute((const void*)mega_fwd, hipFuncAttributeMaxDynamicSharedMemorySize, LDS_BYTES) != hipSuccess) { fprintf(stderr, "kernel_launch: hipFuncSetAttribute failed\n"); grid = -1; return; }
        if (hipOccupancyMaxActiveBlocksPerMultiprocessor(&per_cu, (const void*)mega_fwd, NTHREADS, LDS_BYTES) != hipSuccess || per_cu < 1) {
            fprintf(stderr, "kernel_launch: occupancy query says %d blocks per CU\n", per_cu); (void)hipGetLastError(); }
        grid = cus;
    }
    if (grid < 0) return;
    (void)hipMemsetAsync((char*)d_ws + WS_CTL, 0, CTL_ZERO_BYTES, stream);
    Args a{};
    for (int i = 0; i < 24; ++i) a.in[i] = (const float*)d_in[i];
    a.out = (float*)d_out; a.ws = (unsigned char*)d_ws;
    if (MK_N_LAUNCHES == 1) { a.ph_lo = 0; a.ph_hi = NPHASE; a.use_bar = 1; hipLaunchKernelGGL(mega_fwd, dim3(grid), dim3(NTHREADS), LDS_BYTES, stream, a); }
    else for (int p = 0; p < NPHASE; ++p) { a.ph_lo = p; a.ph_hi = p + 1; a.use_bar = 0; hipLaunchKernelGGL(mega_fwd, dim3(grid), dim3(NTHREADS), LDS_BYTES, stream, a); }
}
```

```cpp
#include <hip/hip_runtime.h>
#include <cstdio>
#include <cstdint>

#define GAS __attribute__((address_space(1)))
#define LAS __attribute__((address_space(3)))
typedef unsigned short bf16;
typedef unsigned v4u __attribute__((ext_vector_type(4)));
typedef unsigned v2u __attribute__((ext_vector_type(2)));
typedef float f32x4 __attribute__((ext_vector_type(4)));
typedef short bf16x8 __attribute__((ext_vector_type(8)));
typedef GAS unsigned gu32;

constexpr int BATCH = 2, SEQ = 8192, D = 1024, NMETA = 16, TLEN = SEQ + NMETA;
constexpr int MREAL = BATCH * SEQ;
constexpr int MROWS = MREAL + NMETA;
constexpr int MPAD = 16640;
constexpr int NHEAD = 8, NKV = 2, HD = 128, KVW = NKV * HD;
constexpr int INW = 5632;
constexpr int C_Q = 0, C_K = 1024, C_V = 1280, C_XR = 1536, C_YR = 2560, C_GA = 3584, C_GR = 4608;
constexpr int NEXP = 16, NGRP = 4, EPG = 4, FF = 512;
constexpr float EPS = 1e-6f;
constexpr float LOG2E = 1.4426950408889634f;
constexpr float QSCALE = 0.08838834764831845f * LOG2E;

constexpr size_t MiB = 1u << 20;
constexpr size_t WS_CTL = 0, CTL_ZERO_BYTES = 1 * MiB;
constexpr size_t WS_WIN = 1 * MiB;
constexpr size_t WS_WATT = 12 * MiB, WS_WREC = 14 * MiB, WS_WOUT = 16 * MiB;
constexpr size_t WS_WGU = 18 * MiB;
constexpr size_t WS_WD = 50 * MiB;
constexpr size_t WS_WLRU = 66 * MiB;
constexpr size_t WS_XN = 18 * MiB;
constexpr size_t WS_Q = 67 * MiB;
constexpr size_t WS_K = 99 * MiB;
constexpr size_t WS_V = 107 * MiB + 512 * 1024;
constexpr size_t WS_XR = 116 * MiB;
constexpr size_t WS_GY = 148 * MiB + 512 * 1024;
constexpr size_t WS_GA = 180 * MiB + 512 * 1024;
constexpr size_t WS_GR = 212 * MiB + 512 * 1024;
constexpr size_t WS_LIST = 244 * MiB + 512 * 1024;
constexpr size_t WS_WLIST = 245 * MiB + 512 * 1024;
constexpr size_t WS_SUM = 246 * MiB + 512 * 1024;
constexpr size_t WS_END = 248 * MiB;
constexpr int CW_TMO = 0, CW_CODE = 1, CW_BAR = 4096, CW_CNT = 8192;

constexpr int RING_BYTES = 131072;
constexpr int LDSCTL_OFF = RING_BYTES, MISC_OFF = LDSCTL_OFF + 320;
constexpr int LDS_BYTES = 147456;
constexpr int NWAVES = 8, NTHREADS = 512;

#define RLX_AGENT __ATOMIC_RELAXED, __HIP_MEMORY_SCOPE_AGENT
#define LDS_WAIT() asm volatile("s_waitcnt lgkmcnt(0)" ::: "memory")
#define VM_WAIT() asm volatile("s_waitcnt vmcnt(0)" ::: "memory")

__device__ __forceinline__ unsigned f2bf(float f) { unsigned u = __builtin_bit_cast(unsigned, f); return (u + 0x7fffu + ((u >> 16) & 1u)) >> 16; }
__device__ __forceinline__ unsigned pk2(float lo, float hi) { return f2bf(lo) | (f2bf(hi) << 16); }
__device__ __forceinline__ float bf2f(unsigned short h) { return __builtin_bit_cast(float, (unsigned)h << 16); }
__device__ __forceinline__ float bflo(unsigned w) { return __builtin_bit_cast(float, w << 16); }
__device__ __forceinline__ float bfhi(unsigned w) { return __builtin_bit_cast(float, w & 0xffff0000u); }
__device__ __forceinline__ float wave_sum(float v) {
#pragma unroll
    for (int o = 1; o < 64; o <<= 1) v += __shfl_xor(v, o);
    return v;
}
template <int CTRL> __device__ __forceinline__ float dpp_mov(float v) { return __builtin_bit_cast(float, __builtin_amdgcn_update_dpp(0, __builtin_bit_cast(int, v), CTRL, 0xf, 0xf, true)); }
__device__ __forceinline__ float wave_sum_dpp(float v) {
    v += dpp_mov<0xB1>(v); v += dpp_mov<0x4E>(v); v += dpp_mov<0x141>(v); v += dpp_mov<0x140>(v);
    v += __builtin_bit_cast(float, __builtin_amdgcn_ds_swizzle(__builtin_bit_cast(int, v), 0x401F));
    auto rr = __builtin_amdgcn_permlane32_swap(__float_as_uint(v), __float_as_uint(v), false, false); return __uint_as_float(rr[0]) + __uint_as_float(rr[1]);
}
__device__ __forceinline__ float wave_max(float v) {
#pragma unroll
    for (int o = 1; o < 64; o <<= 1) v = fmaxf(v, __shfl_xor(v, o));
    return v;
}
__device__ __forceinline__ float sigmoidf_(float x) { return 1.f / (1.f + __expf(-x)); }
__device__ __forceinline__ float gelu_tanh(float x) { const float u = 0.7978845608028654f * (x + 0.044715f * x * x * x); return x / (1.f + __expf(-2.f * u)); }

#define XB_TMO      128
#define XB_XCNT(j)  (256  + 64 * (j))
#define XB_XSUB(j)  (1280 + 64 * (j))
#define XB_XGEN(j)  (2304 + 64 * (j))
#define XB_TOP      3328
#define XB_TOPGEN   3392
#define XCD_BAR_WORDS 3456
#define XB_SPIN_CAP (1u << 24)
__device__ __forceinline__ unsigned xb_ld(unsigned* p)              { return __hip_atomic_load(p, __ATOMIC_RELAXED, __HIP_MEMORY_SCOPE_AGENT); }
__device__ __forceinline__ unsigned xb_add(unsigned* p, unsigned v) { return __hip_atomic_fetch_add(p, v, __ATOMIC_RELAXED, __HIP_MEMORY_SCOPE_AGENT); }
__device__ __forceinline__ unsigned xb_xcc_id() { return (unsigned)__builtin_amdgcn_s_getreg((3 << 11) | 20) & 0xFu; }
#define XB_SPIN(cond, bar) do { unsigned _sp = 0; while (cond) { __builtin_amdgcn_s_sleep(1); \
    if ((++_sp & 255u) == 0u) { if (xb_ld(&(bar)[XB_TMO])) break; if (_sp > XB_SPIN_CAP) { atomicAdd(&(bar)[XB_TMO], 1u); break; } } } } while (0)
struct XcdBarrier { unsigned* bar; unsigned x; volatile LAS unsigned* st; };
__device__ __forceinline__ XcdBarrier xcd_barrier_post(unsigned* bar, volatile LAS unsigned* st) {
    XcdBarrier b; b.bar = bar; b.x = xb_xcc_id(); b.st = st;
    if (threadIdx.x == 0) (void)xb_add(&bar[XB_XCNT(b.x)], 1u);
    return b;
}
__device__ __forceinline__ void xcd_barrier_complete(unsigned* bar, unsigned x, unsigned& nloc, unsigned& nx) {
    const unsigned G = gridDim.x * gridDim.y * gridDim.z;
    unsigned sum, cnt, mine, sp = 0u;
    for (;;) {
        sum = 0u; cnt = 0u; mine = 0u;
#pragma unroll
        for (unsigned j = 0; j < 16; ++j) { const unsigned c = xb_ld(&bar[XB_XCNT(j)]); sum += c; cnt += (c > 0u) ? 1u : 0u; mine = (j == x) ? c : mine; }
        if (sum == G) break;
        __builtin_amdgcn_s_sleep(1);
        if ((++sp & 255u) == 0u) { if (xb_ld(&bar[XB_TMO])) break; if (sp > XB_SPIN_CAP) { atomicAdd(&bar[XB_TMO], 1u); break; } }
    }
    nloc = mine > 0u ? mine : 1u; nx = cnt > 0u ? cnt : 1u;
}
__device__ __forceinline__ void xcd_barrier(const XcdBarrier& b) {
    asm volatile("s_waitcnt vmcnt(0)" ::: "memory");
    __syncthreads();
    if (threadIdx.x == 0) {
        unsigned* bar = b.bar;
        __builtin_amdgcn_s_waitcnt(0);
        unsigned nloc = b.st[0], nx = b.st[1];
        if (nloc == 0u) { xcd_barrier_complete(bar, b.x, nloc, nx); b.st[0] = nloc; b.st[1] = nx; }
        const unsigned old = xb_add(&bar[XB_XSUB(b.x)], 1u);
        const unsigned gen = old / nloc;
        if (old + 1u == (gen + 1u) * nloc) {
            __builtin_amdgcn_fence(__ATOMIC_RELEASE, "agent");
            asm volatile("s_waitcnt vmcnt(0)" ::: "memory");
            const unsigned og = xb_add(&bar[XB_TOP], 1u);
            const unsigned tg = og / nx;
            if (og + 1u == (tg + 1u) * nx) xb_add(&bar[XB_TOPGEN], 1u);
            else XB_SPIN(xb_ld(&bar[XB_TOPGEN]) == tg, bar);
            __builtin_amdgcn_fence(__ATOMIC_ACQUIRE, "agent");
            xb_add(&bar[XB_XGEN(b.x)], 1u);
            asm volatile("s_waitcnt vmcnt(0)" ::: "memory");
        } else {
            XB_SPIN(xb_ld(&bar[XB_XGEN(b.x)]) == gen, bar);
            __builtin_amdgcn_fence(__ATOMIC_ACQUIRE, "agent");
            asm volatile("s_waitcnt vmcnt(0)" ::: "memory");
        }
    }
    __syncthreads();
}

struct Args { const float* in[24]; float* out; unsigned char* ws; int ph_lo, ph_hi, use_bar, pad; };
struct Frame {
    LAS unsigned char* lds;
    volatile LAS unsigned* MISC;
    gu32* ctl;
    int tid, lane, wave, vcu, G;
    float* out; unsigned char* ws;
};
#define I_X 0
#define I_META 1
#define I_GMIX 2
#define I_WIN 3
#define I_CONVW 4
#define I_CONVB 5
#define I_LWA 6
#define I_LBA 7
#define I_LWX 8
#define I_LBX 9
#define I_LAM 10
#define I_SINK 11
#define I_WATT 12
#define I_WREC 13
#define I_WOUT 14
#define I_GFFN 15
#define I_WGRP 16
#define I_BGRP 17
#define I_WRT 18
#define I_BRT 19
#define I_MWG 20
#define I_MWU 21
#define I_MWD 22
#define I_GFIN 23

__device__ __forceinline__ void refresh(Frame& F) { int t = threadIdx.x; asm volatile("" : "+v"(t)); F.tid = t; F.lane = t & 63; F.wave = __builtin_amdgcn_readfirstlane(t >> 6); }
__device__ __forceinline__ void transpose_item(const float* W, int ldw, int k0, int n0, bf16* WT, int ldt, int drow0, int dk0, float scale, LAS float* scr, int lane) {
    float tv[32];
#pragma unroll
    for (int i = 0; i < 32; ++i) tv[i] = W[(size_t)(k0 + 2 * i + (lane >> 5)) * ldw + n0 + (lane & 31)];
#pragma unroll
    for (int i = 0; i < 32; ++i) scr[(2 * i + (lane >> 5)) * 33 + (lane & 31)] = tv[i] * scale;
    LDS_WAIT(); asm volatile("" ::: "memory");
    const int c = lane & 7;
#pragma unroll
    for (int j = 0; j < 4; ++j) { const int n = (lane >> 3) + 8 * j; const LAS float* s = scr + (8 * c) * 33 + n;
        v4u o; o.x = pk2(s[0 * 33], s[1 * 33]); o.y = pk2(s[2 * 33], s[3 * 33]); o.z = pk2(s[4 * 33], s[5 * 33]); o.w = pk2(s[6 * 33], s[7 * 33]);
        *(GAS v4u*)(WT + (size_t)(drow0 + n) * ldt + dk0 + 8 * c) = o; }
    LDS_WAIT(); asm volatile("" ::: "memory");
}
template <int PART> __device__ __forceinline__ void p0_prologue(Frame& F, const Args& A) {
    LAS float* scr = (LAS float*)(F.lds + F.wave * 16384);
    const int gw = F.vcu * NWAVES + F.wave, NGW = F.G * NWAVES, lane = F.lane;
    unsigned char* ws = F.ws;
    constexpr int I_IN = 16 * 176, I_SQ = 16 * 32, I_LRU = 32 * 8, I_MG = 16 * 16, I_MD = 8 * 32;
    constexpr int NITEMS = I_IN + 3 * I_SQ + I_LRU + NEXP * (2 * I_MG + I_MD);
    constexpr int NA = I_IN + 3 * I_SQ + I_LRU;
    for (int it = (PART == 0 ? 0 : NA) + gw; it < (PART == 0 ? NA : NITEMS); it += NGW) {
        int r = it;
        if (r < I_IN) { const int kb = r / 176, nb = r % 176; transpose_item(A.in[I_WIN], INW, 64 * kb, 32 * nb, (bf16*)(ws + WS_WIN), D, 32 * nb, 64 * kb, 1.f, scr, lane); continue; } r -= I_IN;
        if (r < 3 * I_SQ) { const int w = r / I_SQ, q = r % I_SQ, kb = q / 32, nb = q % 32;
            const float* W = w == 0 ? A.in[I_WATT] : (w == 1 ? A.in[I_WREC] : A.in[I_WOUT]); bf16* WT = (bf16*)(ws + (w == 0 ? WS_WATT : (w == 1 ? WS_WREC : WS_WOUT)));
            transpose_item(W, D, 64 * kb, 32 * nb, WT, D, 32 * nb, 64 * kb, 1.f, scr, lane); continue; } r -= 3 * I_SQ;
        if (r < I_LRU) { const int mat = r / 8, q = r % 8, kb = q / 4, nb = q % 4; const int dir = mat >> 4, gate = (mat >> 3) & 1, n = mat & 7;
            const float* W = (gate ? A.in[I_LWX] : A.in[I_LWA]) + (size_t)(dir * 8 + n) * 128 * 128;
            transpose_item(W, 128, 64 * kb, 32 * nb, (bf16*)(ws + WS_WLRU) + (size_t)n * 512 * 128, 128, (dir * 2 + gate) * 128 + 32 * nb, 64 * kb, -LOG2E, scr, lane); continue; } r -= I_LRU;
        { const int e = r / (2 * I_MG + I_MD); int q = r % (2 * I_MG + I_MD);
          if (q < 2 * I_MG) { const int up = q / I_MG; q %= I_MG; const int kb = q / 16, nb = q % 16; const int n0 = 32 * nb;
              const float* W = (up ? A.in[I_MWU] : A.in[I_MWG]) + (size_t)e * D * FF;
              transpose_item(W, FF, 64 * kb, n0, (bf16*)(ws + WS_WGU) + (size_t)e * 1024 * 1024, D, (n0 >> 7) * 256 + (n0 & 127) + up * 128, 64 * kb, 1.f, scr, lane); }
          else { q -= 2 * I_MG; const int kb = q / 32, nb = q % 32;
              transpose_item(A.in[I_MWD] + (size_t)e * FF * D, D, 64 * kb, 32 * nb, (bf16*)(ws + WS_WD) + (size_t)e * 1024 * 512, FF, 32 * nb, 64 * kb, 1.f, scr, lane); } }
    }
    if (PART != 0) return;
    bf16* XN = (bf16*)(F.ws + WS_XN);
    const GAS f32x4* g4 = (const GAS f32x4*)A.in[I_GMIX] + lane;
    auto xrow_ptr = [&](int m) -> const GAS f32x4* { const float* xrow = m < MREAL ? A.in[I_X] + (size_t)m * D : A.in[I_META] + (size_t)((m < MROWS ? m : MREAL) - MREAL) * D; return (const GAS f32x4*)xrow + lane; };
    f32x4 vn[4];
    if (gw < MPAD) { const GAS f32x4* xr = xrow_ptr(gw);
#pragma unroll
        for (int j = 0; j < 4; ++j) vn[j] = xr[64 * j]; }
#pragma unroll 1
    for (int m = gw; m < MPAD; m += NGW) {
        GAS v2u* o8 = (GAS v2u*)(XN + (size_t)m * D) + lane;
        f32x4 v[4]; float s = 0.f;
#pragma unroll
        for (int j = 0; j < 4; ++j) { v[j] = vn[j]; s += (v[j].x * v[j].x + v[j].y * v[j].y) + (v[j].z * v[j].z + v[j].w * v[j].w); }
        if (m + NGW < MPAD) { const GAS f32x4* xr = xrow_ptr(m + NGW);
#pragma unroll
            for (int j = 0; j < 4; ++j) vn[j] = xr[64 * j]; }
        if (m >= MROWS) {
#pragma unroll
            for (int j = 0; j < 4; ++j) o8[64 * j] = (v2u){0u, 0u};
            continue; }
        const float rstd = 1.f / sqrtf(wave_sum(s) * (1.f / D) + EPS);
#pragma unroll
        for (int j = 0; j < 4; ++j) { const f32x4 g = g4[64 * j]; o8[64 * j] = (v2u){pk2(v[j].x * rstd * g.x, v[j].y * rstd * g.y), pk2(v[j].z * rstd * g.z, v[j].w * rstd * g.w)}; }
    }
}

__device__ __forceinline__ void wave_gemm32(const bf16* a0, const bf16* a1, const bf16* b0, const bf16* b1, int K, f32x4 (&acc)[2][2]) {
    for (int k0 = 0; k0 < K; k0 += 32) {
        const bf16x8 A0 = *(const bf16x8*)(a0 + k0), A1 = *(const bf16x8*)(a1 + k0), B0 = *(const bf16x8*)(b0 + k0), B1 = *(const bf16x8*)(b1 + k0);
        acc[0][0] = __builtin_amdgcn_mfma_f32_16x16x32_bf16(A0, B0, acc[0][0], 0, 0, 0);
        acc[0][1] = __builtin_amdgcn_mfma_f32_16x16x32_bf16(A0, B1, acc[0][1], 0, 0, 0);
        acc[1][0] = __builtin_amdgcn_mfma_f32_16x16x32_bf16(A1, B0, acc[1][0], 0, 0, 0);
        acc[1][1] = __builtin_amdgcn_mfma_f32_16x16x32_bf16(A1, B1, acc[1][1], 0, 0, 0);
    }
}
#define ZERO_ACC(acc) do { _Pragma("unroll") for (int _i = 0; _i < 2; ++_i) _Pragma("unroll") for (int _j = 0; _j < 2; ++_j) acc[_i][_j] = (f32x4){0.f, 0.f, 0.f, 0.f}; } while (0)

__device__ __forceinline__ void p1_store(unsigned char* ws, int row, int col, float v) {
    if (col < C_K) { if (row < MREAL) ((bf16*)(ws + WS_Q))[(size_t)row * D + col] = (bf16)f2bf(v * QSCALE); }
    else if (col < C_V) ((bf16*)(ws + WS_K))[(size_t)row * KVW + (col - C_K)] = (bf16)f2bf(v);
    else if (col < C_XR) ((bf16*)(ws + WS_V))[(size_t)row * KVW + (col - C_V)] = (bf16)f2bf(v);
    else if (col < C_YR) ((bf16*)(ws + WS_XR))[(size_t)row * D + (col - C_XR)] = (bf16)f2bf(v);
    else if (col < C_GA) { if (row < MREAL) ((bf16*)(ws + WS_GY))[(size_t)row * D + (col - C_YR)] = (bf16)f2bf(gelu_tanh(v)); }
    else if (col < C_GR) { if (row < MREAL) ((bf16*)(ws + WS_GA))[(size_t)row * D + (col - C_GA)] = (bf16)f2bf(sigmoidf_(v)); }
    else { if (row < MREAL) ((bf16*)(ws + WS_GR))[(size_t)row * D + (col - C_GR)] = (bf16)f2bf(sigmoidf_(v)); }
}
__device__ __forceinline__ void p1_simple(Frame& F, const Args& A, int tn_lo = 0, int tn_hi = 176) {
    const int gw = F.vcu * NWAVES + F.wave, NGW = F.G * NWAVES, lane = F.lane, fr = lane & 15, fq = lane >> 4;
    const bf16* XN = (const bf16*)(F.ws + WS_XN); const bf16* WT = (const bf16*)(F.ws + WS_WIN);
    constexpr int NTM = 513, NTN = INW / 32;
    for (int it = gw; it < NTM * NTN; it += NGW) {
        const int tm = it / NTN, tn = it % NTN, m0 = tm * 32, n0 = tn * 32;
        if (tn < tn_lo || tn >= tn_hi) continue;
        f32x4 acc[2][2]; ZERO_ACC(acc);
        wave_gemm32(XN + (size_t)(m0 + fr) * D + 8 * fq, XN + (size_t)(m0 + 16 + fr) * D + 8 * fq, WT + (size_t)(n0 + fr) * D + 8 * fq, WT + (size_t)(n0 + 16 + fr) * D + 8 * fq, D, acc);
#pragma unroll
        for (int i = 0; i < 2; ++i)
#pragma unroll
            for (int j = 0; j < 2; ++j)
#pragma unroll
                for (int r = 0; r < 4; ++r) p1_store(F.ws, m0 + 16 * i + 4 * fq + r, n0 + 16 * j + fr, acc[i][j][r]);
    }
}

__device__ __forceinline__ void attn_simple(Frame& F, const Args& A) {
    const int gw = F.vcu * NWAVES + F.wave, NGW = F.G * NWAVES, lane = F.lane;
    bf16* Q = (bf16*)(F.ws + WS_Q); const bf16* Kb = (const bf16*)(F.ws + WS_K); const bf16* Vb = (const bf16*)(F.ws + WS_V);
    LAS float* sc = (LAS float*)(F.lds + F.wave * 2048);
    for (int it = gw; it < MREAL * NHEAD; it += NGW) {
        const int r = it >> 3, h = it & 7, b = r / SEQ, s = r % SEQ, kv = h >> 2;
        const float slope2 = exp2f(-(float)(h + 1)) * LOG2E;
        const float sink2 = A.in[I_SINK][h] * LOG2E;
        const unsigned qw = *(const unsigned*)(Q + (size_t)r * D + h * HD + 2 * lane);
        const float q0 = bflo(qw), q1 = bfhi(qw);
        const int s_lo = s - 128 < 0 ? 0 : s - 128, s_hi = s + 128 > SEQ - 1 ? SEQ - 1 : s + 128, nb = s_hi - s_lo + 1, tot = nb + NMETA;
        for (int j = 0; j < tot; ++j) {
            const int krow = j < nb ? b * SEQ + s_lo + j : MREAL + (j - nb);
            const unsigned kw = *(const unsigned*)(Kb + (size_t)krow * KVW + kv * HD + 2 * lane);
            float d = wave_sum(q0 * bflo(kw) + q1 * bfhi(kw));
            if (j < nb) { const int dd = s_lo + j - s; d -= slope2 * (float)(dd < 0 ? -dd : dd); }
            if (lane == 0) sc[j] = d;
        }
        LDS_WAIT(); asm volatile("" ::: "memory");
        float mx = sink2;
        for (int j = lane; j < tot; j += 64) mx = fmaxf(mx, sc[j]);
        mx = wave_max(mx);
        float ls = 0.f;
        for (int j = lane; j < tot; j += 64) { const float p = exp2f(sc[j] - mx); sc[j] = p; ls += p; }
        ls = wave_sum(ls) + exp2f(sink2 - mx);
        LDS_WAIT(); asm volatile("" ::: "memory");
        float o0 = 0.f, o1 = 0.f;
        for (int j = 0; j < tot; ++j) {
            const int krow = j < nb ? b * SEQ + s_lo + j : MREAL + (j - nb);
            const unsigned vw = *(const unsigned*)(Vb + (size_t)krow * KVW + kv * HD + 2 * lane);
            const float p = sc[j]; o0 += p * bflo(vw); o1 += p * bfhi(vw);
        }
        const float il = 1.f / ls;
        *(unsigned*)(Q + (size_t)r * D + h * HD + 2 * lane) = pk2(o0 * il, o1 * il);
        LDS_WAIT(); asm volatile("" ::: "memory");
    }
}

__device__ __forceinline__ int trow(int b, int t) { return t < NMETA ? MREAL + t : b * SEQ + (t - NMETA); }
__device__ __forceinline__ void scan_simple(Frame& F, const Args& A) {
    if (F.vcu >= 16) return;
    const int b = F.vcu >> 3, n = F.vcu & 7, tid = F.tid;
    const int e = tid & 127, gate = (tid >> 7) & 1, kh = tid >> 8;
    LAS float* xcs = (LAS float*)F.lds;
    LAS float* pp = (LAS float*)(F.lds + 8192);
    const bf16* XR = (const bf16*)(F.ws + WS_XR); bf16* GY = (bf16*)(F.ws + WS_GY); float* HF = F.out;
    const float* cw = A.in[I_CONVW]; const float* cb = A.in[I_CONVB];
    for (int dir = 0; dir < 2; ++dir) {
        float w[64];
        { const float* W = (gate ? A.in[I_LWX] : A.in[I_LWA]) + (size_t)(dir * 8 + n) * 128 * 128 + (size_t)(64 * kh) * 128 + e;
#pragma unroll
          for (int dd = 0; dd < 64; ++dd) w[dd] = W[dd * 128]; }
        const int ch = 128 * n + e;
        const float ba = A.in[I_LBA][dir * D + ch], bx = A.in[I_LBX][dir * D + ch], lam = A.in[I_LAM][dir * D + ch];
        const float sp8 = 8.f * log1pf(__expf(-lam));
        float h = 0.f;
        for (int ci = 0; ci < TLEN / 16; ++ci) {
            const int c = dir ? (TLEN / 16 - 1 - ci) : ci, t0 = 16 * c;
            for (int idx = tid; idx < 2048; idx += NTHREADS) { const int tt = idx >> 7, cc = idx & 127, t = t0 + tt, gc = 128 * n + cc;
                float a = cb[gc];
#pragma unroll
                for (int j = 0; j < 4; ++j) { const int ts = t - 2 + j; if (ts >= 0 && ts < TLEN) a += cw[j * D + gc] * bf2f(XR[(size_t)trow(b, ts) * D + gc]); }
                xcs[idx] = a; }
            __syncthreads();
            for (int tt = 0; tt < 16; ++tt) { float p = 0.f; const LAS float* xs = xcs + tt * 128 + 64 * kh;
#pragma unroll
                for (int dd = 0; dd < 64; ++dd) p += w[dd] * xs[dd];
                pp[((kh * 2 + gate) * 16 + tt) * 128 + e] = p; }
            __syncthreads();
            if (tid < 128) {
                for (int k = 0; k < 16; ++k) { const int tt = dir ? 15 - k : k, t = t0 + tt;
                    const float pa = pp[((0 * 2 + 0) * 16 + tt) * 128 + e] + pp[((1 * 2 + 0) * 16 + tt) * 128 + e] + ba;
                    const float px = pp[((0 * 2 + 1) * 16 + tt) * 128 + e] + pp[((1 * 2 + 1) * 16 + tt) * 128 + e] + bx;
                    const float rg = sigmoidf_(pa), ig = sigmoidf_(px);
                    const float la = -sp8 * rg, a = __expf(la), u = sqrtf(-expm1f(2.f * la)) * (ig * xcs[tt * 128 + e]);
                    h = a * h + u;
                    if (t >= NMETA) { const size_t off = (size_t)(b * SEQ + t - NMETA) * D + ch;
                        if (dir == 0) HF[off] = h;
                        else GY[off] = (bf16)f2bf((HF[off] + h) * bf2f(GY[off])); } }
            }
            __syncthreads();
        }
        VM_WAIT(); __syncthreads();
    }
}

__device__ __forceinline__ void merge_simple(Frame& F, const Args& A) {
    const int gw = F.vcu * NWAVES + F.wave, NGW = F.G * NWAVES, lane = F.lane, fr = lane & 15, fq = lane >> 4;
    const bf16* AO = (const bf16*)(F.ws + WS_Q); const bf16* REC = (const bf16*)(F.ws + WS_GY);
    const bf16* WA = (const bf16*)(F.ws + WS_WATT); const bf16* WR = (const bf16*)(F.ws + WS_WREC);
    const bf16* GA = (const bf16*)(F.ws + WS_GA); const bf16* GR = (const bf16*)(F.ws + WS_GR); bf16* M = (bf16*)(F.ws + WS_XR);
    for (int it = gw; it < 512 * 32; it += NGW) {
        const int m0 = (it >> 5) * 32, n0 = (it & 31) * 32;
        f32x4 a1[2][2], a2[2][2]; ZERO_ACC(a1); ZERO_ACC(a2);
        wave_gemm32(AO + (size_t)(m0 + fr) * D + 8 * fq, AO + (size_t)(m0 + 16 + fr) * D + 8 * fq, WA + (size_t)(n0 + fr) * D + 8 * fq, WA + (size_t)(n0 + 16 + fr) * D + 8 * fq, D, a1);
        wave_gemm32(REC + (size_t)(m0 + fr) * D + 8 * fq, REC + (size_t)(m0 + 16 + fr) * D + 8 * fq, WR + (size_t)(n0 + fr) * D + 8 * fq, WR + (size_t)(n0 + 16 + fr) * D + 8 * fq, D, a2);
#pragma unroll
        for (int i = 0; i < 2; ++i)
#pragma unroll
            for (int j = 0; j < 2; ++j)
#pragma unroll
                for (int r = 0; r < 4; ++r) { const size_t off = (size_t)(m0 + 16 * i + 4 * fq + r) * D + n0 + 16 * j + fr;
                    M[off] = (bf16)f2bf(bf2f(GA[off]) * a1[i][j][r] + bf2f(GR[off]) * a2[i][j][r]); }
    }
}
__device__ __forceinline__ void wout_simple(Frame& F, const Args& A) {
    const int gw = F.vcu * NWAVES + F.wave, NGW = F.G * NWAVES, lane = F.lane, fr = lane & 15, fq = lane >> 4;
    const bf16* M = (const bf16*)(F.ws + WS_XR); const bf16* WO = (const bf16*)(F.ws + WS_WOUT);
    for (int it = gw; it < 512 * 32; it += NGW) {
        const int m0 = (it >> 5) * 32, n0 = (it & 31) * 32;
        f32x4 acc[2][2]; ZERO_ACC(acc);
        wave_gemm32(M + (size_t)(m0 + fr) * D + 8 * fq, M + (size_t)(m0 + 16 + fr) * D + 8 * fq, WO + (size_t)(n0 + fr) * D + 8 * fq, WO + (size_t)(n0 + 16 + fr) * D + 8 * fq, D, acc);
#pragma unroll
        for (int i = 0; i < 2; ++i)
#pragma unroll
            for (int j = 0; j < 2; ++j)
#pragma unroll
                for (int r = 0; r < 4; ++r) { const size_t off = (size_t)(m0 + 16 * i + 4 * fq + r) * D + n0 + 16 * j + fr; F.out[off] = A.in[I_X][off] + acc[i][j][r]; }
    }
}
__device__ __forceinline__ void route_simple(Frame& F, const Args& A, bool dry = false, bool dummy = false) {
    const int gw = F.vcu * NWAVES + F.wave, NGW = F.G * NWAVES, lane = F.lane;
    bf16* N2 = (bf16*)(F.ws + WS_Q);
    unsigned* LIST = (unsigned*)(F.ws + (dummy ? WS_GY : WS_LIST)); float* WLIST = (float*)(F.ws + (dummy ? WS_GY + 2 * MiB : WS_WLIST)); const int cw = dummy ? CW_CNT + 2048 : CW_CNT;
    const GAS f32x4* g4 = (const GAS f32x4*)A.in[I_GFFN] + lane;
    const f32x4* wg4 = (const f32x4*)A.in[I_WGRP]; const f32x4* wr4 = (const f32x4*)A.in[I_WRT];
    for (int m = gw; m < MREAL; m += NGW) {
        const GAS f32x4* hr = (const GAS f32x4*)(F.out + (size_t)m * D) + lane;
        f32x4 v[4]; float s = 0.f;
#pragma unroll
        for (int j = 0; j < 4; ++j) { v[j] = hr[64 * j]; s += (v[j].x * v[j].x + v[j].y * v[j].y) + (v[j].z * v[j].z + v[j].w * v[j].w); }
        const float rstd = 1.f / sqrtf(wave_sum(s) * (1.f / D) + EPS);
        GAS v2u* o8 = (GAS v2u*)(N2 + (size_t)m * D) + lane;
        float lg[20];
#pragma unroll
        for (int o = 0; o < 20; ++o) lg[o] = 0.f;
#pragma unroll
        for (int j = 0; j < 4; ++j) { const f32x4 g = g4[64 * j]; v[j].x *= rstd * g.x; v[j].y *= rstd * g.y; v[j].z *= rstd * g.z; v[j].w *= rstd * g.w;
            o8[64 * j] = (v2u){pk2(v[j].x, v[j].y), pk2(v[j].z, v[j].w)};
#pragma unroll
            for (int i = 0; i < 4; ++i) { const int col = 256 * j + 4 * lane + i; const float x = v[j][i];
                const f32x4 a = wg4[col]; lg[0] += x * a.x; lg[1] += x * a.y; lg[2] += x * a.z; lg[3] += x * a.w;
#pragma unroll
                for (int q = 0; q < 4; ++q) { const f32x4 c = wr4[col * 4 + q]; lg[4 + 4 * q] += x * c.x; lg[5 + 4 * q] += x * c.y; lg[6 + 4 * q] += x * c.z; lg[7 + 4 * q] += x * c.w; } } }
#pragma unroll
        for (int o = 0; o < 20; ++o) lg[o] = wave_sum(lg[o]);
        if (lane == 0 && !dry) {
            float gl[4]; int gi = 0;
#pragma unroll
            for (int o = 0; o < 4; ++o) gl[o] = lg[o] + A.in[I_BGRP][o];
            float gm = gl[0];
#pragma unroll
            for (int o = 1; o < 4; ++o) if (gl[o] > gm) { gm = gl[o]; gi = o; }
            float gs = 0.f;
#pragma unroll
            for (int o = 0; o < 4; ++o) gs += __expf(gl[o] - gm);
            const float gp = 1.f / gs;
            float el[4];
#pragma unroll
            for (int o = 0; o < 4; ++o) { float x = 0.f;
#pragma unroll
                for (int g = 0; g < 4; ++g) x = (g == gi) ? lg[4 + 4 * g + o] + A.in[I_BRT][4 * g + o] : x;
                el[o] = x; }
            int i1 = 0; float e1 = el[0];
#pragma unroll
            for (int o = 1; o < 4; ++o) if (el[o] > e1) { e1 = el[o]; i1 = o; }
            int i2 = -1; float e2 = -3.0e38f;
#pragma unroll
            for (int o = 0; o < 4; ++o) if (o != i1 && el[o] > e2) { e2 = el[o]; i2 = o; }
            const float w1 = gp / (1.f + __expf(e2 - e1)), w2 = gp - w1;
            const int x1 = gi * EPG + i1, x2 = gi * EPG + i2;
            const unsigned p1 = atomicAdd((unsigned*)(F.ctl + cw + 64 * x1), 1u), p2 = atomicAdd((unsigned*)(F.ctl + cw + 64 * x2), 1u);
            LIST[x1 * MREAL + p1] = (unsigned)m; WLIST[x1 * MREAL + p1] = w1;
            LIST[x2 * MREAL + p2] = (unsigned)m | (1u << 14); WLIST[x2 * MREAL + p2] = w2;
        }
    }
}
__device__ __forceinline__ void route_fast(Frame& F, const Args& A, bool dummy = false) {
    const int gw = F.vcu * NWAVES + F.wave, NGW = F.G * NWAVES, lane = F.lane, w = F.wave, tid = F.tid;
    bf16* N2 = (bf16*)(F.ws + WS_Q);
    LAS f32x4* wl = (LAS f32x4*)F.lds;
    LAS float* lgs = (LAS float*)(F.lds + 81920);
    LAS int* dec_e = (LAS int*)(F.lds + 90112);
    LAS float* dec_w = (LAS float*)(F.lds + 90112 + 512);
    LAS int* dec_p = (LAS int*)(F.lds + 90112 + 1024);
    LAS int* hist = (LAS int*)(F.lds + 90112 + 1536);
    LAS int* base = (LAS int*)(F.lds + 90112 + 1600);
    if (tid < 16) hist[tid] = 0;
    { const f32x4* wg4 = (const f32x4*)A.in[I_WGRP]; const f32x4* wr4 = (const f32x4*)A.in[I_WRT];
      for (int idx = tid; idx < 80 * 64; idx += NTHREADS) { const int e = idx >> 6, l = idx & 63, j = e / 20, i = (e / 5) & 3, q = e % 5, col = 256 * j + 4 * l + i;
          wl[idx] = q == 0 ? wg4[col] : wr4[col * 4 + q - 1]; } }
    __syncthreads();
    const GAS f32x4* g4 = (const GAS f32x4*)A.in[I_GFFN] + lane;
    static_assert(MREAL == 8 * 2048, "eight rows per wave on a 256-workgroup grid");
    f32x4 vn[4];
    { const GAS f32x4* hr = (const GAS f32x4*)(F.out + (size_t)gw * D) + lane;
#pragma unroll
      for (int j = 0; j < 4; ++j) vn[j] = hr[64 * j]; }
#pragma unroll 1
    for (int k = 0; k < 8; ++k) { const int m = gw + k * NGW;
        f32x4 v[4]; float s = 0.f;
#pragma unroll
        for (int j = 0; j < 4; ++j) { v[j] = vn[j]; s += (v[j].x * v[j].x + v[j].y * v[j].y) + (v[j].z * v[j].z + v[j].w * v[j].w); }
        if (k < 7) { const GAS f32x4* hr = (const GAS f32x4*)(F.out + (size_t)(m + NGW) * D) + lane;
#pragma unroll
            for (int j = 0; j < 4; ++j) vn[j] = hr[64 * j]; }
        const float rstd = 1.f / sqrtf(wave_sum_dpp(s) * (1.f / D) + EPS);
        GAS v2u* o8 = (GAS v2u*)(N2 + (size_t)m * D) + lane;
#pragma unroll
        for (int j = 0; j < 4; ++j) { const f32x4 g = g4[64 * j]; v[j].x *= rstd * g.x; v[j].y *= rstd * g.y; v[j].z *= rstd * g.z; v[j].w *= rstd * g.w;
            o8[64 * j] = (v2u){pk2(v[j].x, v[j].y), pk2(v[j].z, v[j].w)}; }
        f32x4 lg[5];
#pragma unroll
        for (int q = 0; q < 5; ++q) lg[q] = (f32x4){0.f, 0.f, 0.f, 0.f};
#pragma unroll
        for (int j = 0; j < 4; ++j)
#pragma unroll
            for (int i = 0; i < 4; ++i) { const float x = v[j][i];
#pragma unroll
                for (int q = 0; q < 5; ++q) lg[q] += wl[((j * 4 + i) * 5 + q) * 64 + lane] * x;
                if (i & 1) __builtin_amdgcn_sched_barrier(0); }
#pragma unroll
        for (int q = 0; q < 5; ++q)
#pragma unroll
            for (int c = 0; c < 4; ++c) lg[q][c] = wave_sum_dpp(lg[q][c]);
        if (lane == 0) {
#pragma unroll
            for (int q = 0; q < 5; ++q) *(LAS f32x4*)(lgs + (w * 8 + k) * 20 + 4 * q) = lg[q]; }
    }
    LDS_WAIT();
    if (lane < 8 && gw + lane * NGW < MREAL) { const LAS float* L = lgs + (w * 8 + lane) * 20;
        float gl[4]; int gi = 0;
#pragma unroll
        for (int o = 0; o < 4; ++o) gl[o] = L[o] + A.in[I_BGRP][o];
        float gm = gl[0];
#pragma unroll
        for (int o = 1; o < 4; ++o) if (gl[o] > gm) { gm = gl[o]; gi = o; }
        float gs = 0.f;
#pragma unroll
        for (int o = 0; o < 4; ++o) gs += __expf(gl[o] - gm);
        const float gp = 1.f / gs;
        float el[4];
#pragma unroll
        for (int o = 0; o < 4; ++o) el[o] = L[4 + 4 * gi + o] + A.in[I_BRT][4 * gi + o];
        int i1 = 0; float e1 = el[0];
#pragma unroll
        for (int o = 1; o < 4; ++o) if (el[o] > e1) { e1 = el[o]; i1 = o; }
        int i2 = -1; float e2 = -3.0e38f;
#pragma unroll
        for (int o = 0; o < 4; ++o) if (o != i1 && el[o] > e2) { e2 = el[o]; i2 = o; }
        const float w1 = gp / (1.f + __expf(e2 - e1)), w2 = gp - w1;
        const int x1 = gi * EPG + i1, x2 = gi * EPG + i2, rr = w * 8 + lane;
        dec_e[2 * rr] = x1; dec_e[2 * rr + 1] = x2; dec_w[2 * rr] = w1; dec_w[2 * rr + 1] = w2;
        dec_p[2 * rr] = __hip_atomic_fetch_add(hist + x1, 1, __ATOMIC_RELAXED, __HIP_MEMORY_SCOPE_WORKGROUP);
        dec_p[2 * rr + 1] = __hip_atomic_fetch_add(hist + x2, 1, __ATOMIC_RELAXED, __HIP_MEMORY_SCOPE_WORKGROUP);
    }
    __syncthreads();
    if (tid < 16) { const int c = hist[tid]; base[tid] = c ? (int)atomicAdd((unsigned*)(F.ctl + (dummy ? CW_CNT + 2048 : CW_CNT) + 64 * tid), (unsigned)c) : 0; }
    __syncthreads();
    if (tid < 128) { const int rr = tid >> 1, slot = tid & 1, wv = rr >> 3, k = rr & 7, m = F.vcu * NWAVES + wv + k * NGW;
        unsigned* LIST = (unsigned*)(F.ws + (dummy ? WS_GY : WS_LIST)); float* WLIST = (float*)(F.ws + (dummy ? WS_GY + 2 * MiB : WS_WLIST));
        if (m < MREAL) { const int e = dec_e[tid], pos = base[e] + dec_p[tid];
            LIST[e * MREAL + pos] = (unsigned)m | ((unsigned)slot << 14); WLIST[e * MREAL + pos] = dec_w[tid]; } }
    __syncthreads();
}
struct ExpMap { int cnt[NEXP]; int off[NEXP]; };
__device__ __forceinline__ void moe1_simple(Frame& F, const Args& A) {
    const int gw = F.vcu * NWAVES + F.wave, NGW = F.G * NWAVES, lane = F.lane, fr = lane & 15, fq = lane >> 4;
    const bf16* N2 = (const bf16*)(F.ws + WS_Q); const unsigned* LIST = (const unsigned*)(F.ws + WS_LIST); bf16* HDN = (bf16*)(F.ws + WS_XR);
    int base = 0, off = 0;
    for (int e = 0; e < NEXP; ++e) {
        const int cnt = (int)__hip_atomic_load(F.ctl + CW_CNT + 64 * e, RLX_AGENT);
        const int ntm = (cnt + 31) >> 5, nit = ntm * 16;
        const bf16* WG = (const bf16*)(F.ws + WS_WGU) + (size_t)e * 1024 * 1024;
        int first = gw - (base % NGW); if (first < 0) first += NGW;
        for (int q = first; q < nit; q += NGW) {
            const int tm = q >> 4, tn = q & 15, j0 = 32 * tn;
            int i0 = tm * 32 + fr, i1 = i0 + 16; if (i0 >= cnt) i0 = 0; if (i1 >= cnt) i1 = 0;
            const int t0 = LIST[e * MREAL + i0] & 0x3fff, t1 = LIST[e * MREAL + i1] & 0x3fff;
            const int br = (j0 >> 7) * 256 + (j0 & 127);
            f32x4 ag[2][2], au[2][2]; ZERO_ACC(ag); ZERO_ACC(au);
            wave_gemm32(N2 + (size_t)t0 * D + 8 * fq, N2 + (size_t)t1 * D + 8 * fq, WG + (size_t)(br + fr) * D + 8 * fq, WG + (size_t)(br + 16 + fr) * D + 8 * fq, D, ag);
            wave_gemm32(N2 + (size_t)t0 * D + 8 * fq, N2 + (size_t)t1 * D + 8 * fq, WG + (size_t)(br + 128 + fr) * D + 8 * fq, WG + (size_t)(br + 144 + fr) * D + 8 * fq, D, au);
#pragma unroll
            for (int i = 0; i < 2; ++i)
#pragma unroll
                for (int j = 0; j < 2; ++j)
#pragma unroll
                    for (int r = 0; r < 4; ++r) { const int ii = tm * 32 + 16 * i + 4 * fq + r; const float g = ag[i][j][r], u = au[i][j][r];
                        HDN[(size_t)(off + ii) * FF + j0 + 16 * j + fr] = (bf16)f2bf(g / (1.f + __expf(-g)) * u); }
        }
        base += nit; off += (cnt + 255) & ~255;
    }
}
__device__ __forceinline__ void moe2_simple(Frame& F, const Args& A) {
    const int gw = F.vcu * NWAVES + F.wave, NGW = F.G * NWAVES, lane = F.lane, fr = lane & 15, fq = lane >> 4;
    const unsigned* LIST = (const unsigned*)(F.ws + WS_LIST); const float* WLIST = (const float*)(F.ws + WS_WLIST);
    const bf16* HDN = (const bf16*)(F.ws + WS_XR); bf16* Y = (bf16*)(F.ws + WS_GA);
    int base = 0, off = 0;
    for (int e = 0; e < NEXP; ++e) {
        const int cnt = (int)__hip_atomic_load(F.ctl + CW_CNT + 64 * e, RLX_AGENT);
        const int ntm = (cnt + 31) >> 5, nit = ntm * 32;
        const bf16* WD = (const bf16*)(F.ws + WS_WD) + (size_t)e * 1024 * 512;
        int first = gw - (base % NGW); if (first < 0) first += NGW;
        for (int q = first; q < nit; q += NGW) {
            const int tm = q >> 5, tn = q & 31, n0 = 32 * tn;
            f32x4 acc[2][2]; ZERO_ACC(acc);
            const bf16* a0 = HDN + (size_t)(off + tm * 32 + fr) * FF + 8 * fq;
            wave_gemm32(a0, a0 + 16 * FF, WD + (size_t)(n0 + fr) * FF + 8 * fq, WD + (size_t)(n0 + 16 + fr) * FF + 8 * fq, FF, acc);
#pragma unroll
            for (int i = 0; i < 2; ++i)
#pragma unroll
                for (int r = 0; r < 4; ++r) { const int ii = tm * 32 + 16 * i + 4 * fq + r;
                    if (ii < cnt) { const unsigned le = LIST[e * MREAL + ii]; const float w = WLIST[e * MREAL + ii]; const size_t row = (size_t)(le >> 14) * MREAL + (le & 0x3fff);
#pragma unroll
                        for (int j = 0; j < 2; ++j) Y[row * D + n0 + 16 * j + fr] = (bf16)f2bf(w * acc[i][j][r]); } }
        }
        base += nit; off += (cnt + 255) & ~255;
    }
}
__device__ __forceinline__ void final_rows(Frame& F, const Args& A, bool dry = false) {
    const int gw = F.vcu * NWAVES + F.wave, NGW = F.G * NWAVES, lane = F.lane;
    const bf16* Y = (const bf16*)(F.ws + WS_GA);
    const GAS f32x4* g4 = (const GAS f32x4*)A.in[I_GFIN] + lane;
    f32x4 hn[4]; v2u an[4], cn[4];
#define FIN_LOAD(m_) do { const GAS f32x4* hr_ = (const GAS f32x4*)(F.out + (size_t)(m_) * D) + lane; const GAS v2u* y0_ = (const GAS v2u*)(Y + (size_t)(m_) * D) + lane; const GAS v2u* y1_ = (const GAS v2u*)(Y + (size_t)(MREAL + (m_)) * D) + lane; \
        _Pragma("unroll") for (int j = 0; j < 4; ++j) { hn[j] = hr_[64 * j]; an[j] = y0_[64 * j]; cn[j] = y1_[64 * j]; } } while (0)
    if (gw < MREAL) FIN_LOAD(gw);
#pragma unroll 1
    for (int m = gw; m < MREAL; m += NGW) {
        GAS f32x4* hr = (GAS f32x4*)(F.out + (size_t)m * D) + lane;
        f32x4 v[4]; float s = 0.f;
#pragma unroll
        for (int j = 0; j < 4; ++j) { v[j] = hn[j]; const v2u a = an[j], c = cn[j];
            v[j].x += bflo(a.x) + bflo(c.x); v[j].y += bfhi(a.x) + bfhi(c.x); v[j].z += bflo(a.y) + bflo(c.y); v[j].w += bfhi(a.y) + bfhi(c.y);
            s += (v[j].x * v[j].x + v[j].y * v[j].y) + (v[j].z * v[j].z + v[j].w * v[j].w); }
        if (m + NGW < MREAL) FIN_LOAD(m + NGW);
        const float rstd = 1.f / sqrtf(wave_sum(s) * (1.f / D) + EPS);
#pragma unroll
        for (int j = 0; j < 4; ++j) { const f32x4 g = g4[64 * j]; GAS f32x4* dst = dry ? (GAS f32x4*)((float*)(F.ws + WS_XR) + (size_t)m * D) + lane : hr; dst[64 * j] = (f32x4){v[j].x * rstd * g.x, v[j].y * rstd * g.y, v[j].z * rstd * g.z, v[j].w * rstd * g.w}; }
    }
#undef FIN_LOAD
}

namespace pg8 {
constexpr int BM = 256, BK = 64, HALF = 128, HTB = HALF * BK * 2, STAGE_BYTES = 8 * HTB, NXCD = 8, WGM = 8;
__host__ __device__ __forceinline__ int lds_byte(int r, int c) { const int st = (r >> 4) * 2 + (c >> 5), rr = r & 15, cc = c & 31, ob = rr * 64 + cc * 2; return st * 1024 + (ob ^ (((ob >> 9) & 1) << 5)); }
__host__ __device__ __forceinline__ void stage_rc(int b, int& R, int& C) { const int st = b / 1024, sb = b % 1024, swz = sb ^ (((sb >> 9) & 1) << 5); R = (st >> 1) * 16 + swz / 64; C = (st & 1) * 32 + (swz % 64) / 2; }
__host__ __device__ __forceinline__ int perm32(int rho) { const int n = rho >> 4, i = rho & 15; return 8 * (i >> 2) + 4 * n + (i & 3); }
struct Unit { int pm, pn, e, cnt, off, slot; };
typedef float f32x2_t __attribute__((ext_vector_type(2))); typedef __bf16 bf16x2_t __attribute__((ext_vector_type(2)));
__device__ __forceinline__ unsigned cvt_pk_bf16(float lo, float hi) { f32x2_t v = {lo, hi}; bf16x2_t b = __builtin_convertvector(v, bf16x2_t); return __builtin_bit_cast(unsigned, b); }

struct StaticOrder {
    int nM, nN, nwg, G, c, K; const char* A; const char* Bt; int i0 = 0, nround = 1 << 30; bool dup_last = false;
    __device__ void init(const bf16* A_, const bf16* Bt_, int M, int N, int K_, int G_, int c_) { A = (const char*)A_; Bt = (const char*)Bt_; K = K_; nM = M / BM; nN = N / BM; nwg = nM * nN; G = G_; c = c_; }
    __device__ bool next(int i, Unit& u) const {
        if (i >= nround) return false;
        long L = (long)(i + i0) * G + c; if (L >= nwg) { if (!dup_last || L - G >= nwg) return false; L = c; }
        int wgid = (int)L; { const int q = nwg / NXCD, r = nwg % NXCD, xcd = wgid % NXCD, off = wgid / NXCD; wgid = (xcd < r ? xcd * (q + 1) : r * (q + 1) + (xcd - r) * q) + off; }
        const int nig = WGM * nN, gid = wgid / nig, fm = gid * WGM, gsz = (nM - fm) < WGM ? (nM - fm) : WGM;
        u.pm = fm + ((wgid % nig) % gsz); u.pn = (wgid % nig) / gsz; return true;
    }
    __device__ __forceinline__ const char* a_base(const Unit& u) const { return A + (size_t)u.pm * BM * K * 2; }
    __device__ __forceinline__ const char* b_base(const Unit& u) const { return Bt + (size_t)u.pn * BM * K * 2; }
    __device__ __forceinline__ void a_offsets(const Unit&, const int (&RA)[2], const int (&CA)[2], unsigned (&v)[2][2]) const {
#pragma unroll
        for (int h = 0; h < 2; ++h)
#pragma unroll
            for (int i = 0; i < 2; ++i) v[h][i] = (unsigned)((h * HALF + RA[i]) * K + CA[i]) * 2u; }
};

template <class Epi, class Sched, bool ALIGN_EPI>
__device__ __forceinline__ void gemm_phase(LAS unsigned char* lds, const int K, const Sched& S, const Epi& E) {
    int tid = threadIdx.x; asm volatile("" : "+v"(tid));
    const int wid = __builtin_amdgcn_readfirstlane(tid >> 6), lane = tid & 63, wr = wid >> 2, wc = wid & 3, fr = lane & 15, fq = lane >> 4;
    const int nt = K / BK;
    int RA[2], CA[2]; unsigned voffB[2];
#pragma unroll
    for (int i = 0; i < 2; ++i) { int R, C; stage_rc(tid * 16 + i * 8192, R, C); const int Rb = Epi::PERM ? ((R & ~31) + perm32(R & 31)) : R; RA[i] = R; CA[i] = C; voffB[i] = (unsigned)(Rb * K + C) * 2u; }
    const size_t kstep = (size_t)(BK * 2);
    const size_t hstep = (size_t)HALF * K * 2;
    const unsigned ldsw = (unsigned)wid * 1024u;
    const int aoff = lds_byte(wr * 64 + fr, fq * 8), boff = lds_byte(wc * 32 + fr, fq * 8);
#define PG8_SA(b, h) (((b) * 2 + (h)) * HTB)
#define PG8_SB(b, h) ((4 + (b) * 2 + (h)) * HTB)
#define PG8_STAGE2(bufoff, gbase, o0, o1) do { \
        __builtin_amdgcn_global_load_lds((const unsigned*)((const char*)(gbase) + (o0)), (LAS unsigned*)(lds + (bufoff) + ldsw), 16, 0, 0); \
        __builtin_amdgcn_global_load_lds((const unsigned*)((const char*)(gbase) + (o1)), (LAS unsigned*)(lds + (bufoff) + ldsw + 8192), 16, 0, 0); } while (0)
#define PG8_STB(b, h, gbase) PG8_STAGE2(PG8_SB(b, h), (gbase) + (h) * hstep, voffB[0], voffB[1])
#define PG8_LDA(dst, b, h) do { _Pragma("unroll") for (int m = 0; m < 4; ++m) _Pragma("unroll") for (int k = 0; k < 2; ++k) dst[m][k] = *(const LAS bf16x8*)(lds + PG8_SA(b, h) + aoff + m * 2048 + k * 1024); } while (0)
#define PG8_LDB(dst, b, h) do { _Pragma("unroll") for (int n = 0; n < 2; ++n) _Pragma("unroll") for (int k = 0; k < 2; ++k) dst[n][k] = *(const LAS bf16x8*)(lds + PG8_SB(b, h) + boff + n * 2048 + k * 1024); } while (0)
#define PG8_MMA(ai, bj, At, Bt) do { __builtin_amdgcn_s_setprio(1); _Pragma("unroll") for (int m = 0; m < 4; ++m) _Pragma("unroll") for (int n = 0; n < 2; ++n) _Pragma("unroll") for (int k = 0; k < 2; ++k) \
        acc[ai][bj][m][n] = __builtin_amdgcn_mfma_f32_16x16x32_bf16(Bt[n][k], At[m][k], acc[ai][bj][m][n], 0, 0, 0); __builtin_amdgcn_s_setprio(0); } while (0)
#define PG8_WAIT_V(n) asm volatile("s_waitcnt vmcnt(" #n ")" ::: "memory")
#define PG8_WAIT_L(n) asm volatile("s_waitcnt lgkmcnt(" #n ")" ::: "memory")
#define PG8_BAR __builtin_amdgcn_s_barrier()
#define PG8_SCHED __builtin_amdgcn_sched_barrier(0)
    Unit cur, nxt; int ui = 0;
    if (!S.next(0, cur)) return;
    f32x4 acc[2][2][4][2];
#pragma unroll
    for (int a = 0; a < 2; ++a)
#pragma unroll
        for (int b = 0; b < 2; ++b)
#pragma unroll
            for (int m = 0; m < 4; ++m)
#pragma unroll
                for (int n = 0; n < 2; ++n) acc[a][b][m][n] = (f32x4){0.f, 0.f, 0.f, 0.f};
    bf16x8 At[4][2], B0[2][2], B1[2][2];
    unsigned va[2][2], vn[2][2];
    S.a_offsets(cur, RA, CA, va);
    const char* cA = S.a_base(cur); const char* cB = S.b_base(cur);
    PG8_STB(0, 0, cB); PG8_STB(0, 1, cB); PG8_STAGE2(PG8_SA(0, 0), cA, va[0][0], va[0][1]); PG8_STAGE2(PG8_SA(0, 1), cA, va[1][0], va[1][1]);
    if (wr == 1) PG8_BAR;
    PG8_WAIT_V(2); PG8_BAR;
    PG8_STB(1, 0, cB + kstep); PG8_STAGE2(PG8_SA(1, 0), cA + kstep, va[0][0], va[0][1]); PG8_STB(1, 1, cB + kstep);
    PG8_WAIT_V(6); PG8_BAR;
    for (;;) {
        const bool has_next = S.next(ui + 1, nxt);
        const char* nA = cA; const char* nB = cB;
        if (has_next) { nA = S.a_base(nxt); nB = S.b_base(nxt); S.a_offsets(nxt, RA, CA, vn); }
        else {
#pragma unroll
            for (int h = 0; h < 2; ++h)
#pragma unroll
                for (int i = 0; i < 2; ++i) vn[h][i] = va[h][i]; }
        for (int t = 0; t < nt; t += 2) {
            const bool last = (t == nt - 2);
            const char* a1 = cA + (size_t)(t + 1) * kstep;
            const char* a2 = last ? nA : cA + (size_t)(t + 2) * kstep; const char* b2 = last ? nB : cB + (size_t)(t + 2) * kstep;
            const char* a3 = a2 + kstep; const char* b3 = b2 + kstep;
            const unsigned s00 = last ? vn[0][0] : va[0][0], s01 = last ? vn[0][1] : va[0][1], s10 = last ? vn[1][0] : va[1][0], s11 = last ? vn[1][1] : va[1][1];
            PG8_LDB(B0, 0, 0); PG8_LDB(B1, 0, 1); PG8_SCHED; PG8_LDA(At, 0, 0); PG8_STAGE2(PG8_SA(1, 1), a1, va[1][0], va[1][1]);
            PG8_WAIT_V(8); PG8_WAIT_L(0); PG8_BAR; PG8_MMA(0, 0, At, B0); PG8_MMA(0, 1, At, B1); PG8_BAR; PG8_SCHED;
            PG8_LDA(At, 0, 1); PG8_STB(0, 0, b2); PG8_STB(0, 1, b2); PG8_STAGE2(PG8_SA(0, 0), a2, s00, s01);
            PG8_WAIT_V(8); PG8_WAIT_L(0); PG8_BAR; PG8_MMA(1, 0, At, B0); PG8_MMA(1, 1, At, B1); PG8_BAR; PG8_SCHED;
            PG8_LDB(B0, 1, 0); PG8_LDB(B1, 1, 1); PG8_SCHED; PG8_LDA(At, 1, 0); PG8_STAGE2(PG8_SA(0, 1), a2, s10, s11);
            PG8_WAIT_V(8); PG8_WAIT_L(0); PG8_BAR; PG8_MMA(0, 0, At, B0); PG8_MMA(0, 1, At, B1); PG8_BAR; PG8_SCHED;
            PG8_LDA(At, 1, 1); PG8_STB(1, 0, b3); PG8_STB(1, 1, b3); PG8_STAGE2(PG8_SA(1, 0), a3, s00, s01);
            PG8_WAIT_V(8); PG8_WAIT_L(0); PG8_BAR; PG8_MMA(1, 0, At, B0); PG8_MMA(1, 1, At, B1); PG8_BAR; PG8_SCHED;
        }
        if constexpr (ALIGN_EPI) { if (wr == 0) PG8_BAR; }
        E(acc, cur, wr, wc, fr, fq);
        if (!has_next) break;
#pragma unroll
        for (int a = 0; a < 2; ++a)
#pragma unroll
            for (int b = 0; b < 2; ++b)
#pragma unroll
                for (int m = 0; m < 4; ++m)
#pragma unroll
                    for (int n = 0; n < 2; ++n) acc[a][b][m][n] = (f32x4){0.f, 0.f, 0.f, 0.f};
        cur = nxt; cA = nA; cB = nB; ++ui;
#pragma unroll
        for (int h = 0; h < 2; ++h)
#pragma unroll
            for (int i = 0; i < 2; ++i) va[h][i] = vn[h][i];
        if constexpr (ALIGN_EPI) { if (wr == 1) PG8_BAR; }
    }
    PG8_WAIT_V(0);
    if constexpr (!ALIGN_EPI) { if (wr == 0) PG8_BAR; }
    PG8_BAR;
#undef PG8_SA
#undef PG8_SB
#undef PG8_STAGE2
#undef PG8_STB
#undef PG8_LDA
#undef PG8_LDB
#undef PG8_MMA
#undef PG8_WAIT_V
#undef PG8_WAIT_L
#undef PG8_BAR
#undef PG8_SCHED
}

__device__ __forceinline__ float fast_sigmoid(float x) { return __builtin_amdgcn_rcpf(1.f + __builtin_amdgcn_exp2f(-LOG2E * x)); }
__device__ __forceinline__ float fast_gelu_tanh(float x) { const float u = x * (0.7978845608028654f + 0.035677408136300125f * x * x); return x * __builtin_amdgcn_rcpf(1.f + __builtin_amdgcn_exp2f(-2.f * LOG2E * u)); }
template <int ACT> __device__ __forceinline__ float actf(float v) { if (ACT == 1) return v * QSCALE; if (ACT == 2) return fast_gelu_tanh(v); if (ACT == 3) return fast_sigmoid(v); return v; }
template <int ACT> __device__ __forceinline__ void store_tile_bf16(const f32x4 (&acc)[2][2][4][2], bf16* base, int ld, int row0, int col0) {
#pragma unroll
    for (int ai = 0; ai < 2; ++ai)
#pragma unroll
        for (int m = 0; m < 4; ++m) { bf16* rowp = base + (size_t)(row0 + ai * HALF + m * 16) * ld + col0;
#pragma unroll
            for (int bj = 0; bj < 2; ++bj) { const f32x4 v0 = acc[ai][bj][m][0], v1 = acc[ai][bj][m][1]; v4u w;
                w.x = cvt_pk_bf16(actf<ACT>(v0[0]), actf<ACT>(v0[1])); w.y = cvt_pk_bf16(actf<ACT>(v0[2]), actf<ACT>(v0[3]));
                w.z = cvt_pk_bf16(actf<ACT>(v1[0]), actf<ACT>(v1[1])); w.w = cvt_pk_bf16(actf<ACT>(v1[2]), actf<ACT>(v1[3]));
                *(v4u*)(rowp + bj * HALF) = w; } }
}
struct EpiZ {
    static constexpr bool PERM = true; unsigned char* ws;
    __device__ __forceinline__ void operator()(const f32x4 (&acc)[2][2][4][2], const Unit& u, int wr, int wc, int fr, int fq) const {
        const int pn = u.pn, row0 = u.pm * BM + wr * 64 + fr, cl = wc * 32 + 8 * fq;
        const bool meta = (u.pm == MREAL / BM);
        if (pn < 4) { if (!meta) store_tile_bf16<1>(acc, (bf16*)(ws + WS_Q), D, row0, pn * BM + cl); }
        else if (pn == 4) store_tile_bf16<0>(acc, (bf16*)(ws + WS_K), KVW, row0, cl);
        else if (pn == 5) store_tile_bf16<0>(acc, (bf16*)(ws + WS_V), KVW, row0, cl);
        else if (pn < 10) store_tile_bf16<0>(acc, (bf16*)(ws + WS_XR), D, row0, (pn - 6) * BM + cl);
        else if (pn < 14) { if (!meta) store_tile_bf16<2>(acc, (bf16*)(ws + WS_GY), D, row0, (pn - 10) * BM + cl); }
        else if (pn < 18) { if (!meta) store_tile_bf16<3>(acc, (bf16*)(ws + WS_GA), D, row0, (pn - 14) * BM + cl); }
        else { if (!meta) store_tile_bf16<3>(acc, (bf16*)(ws + WS_GR), D, row0, (pn - 18) * BM + cl); }
    }
};
template <bool ADD> struct EpiGate {
    static constexpr bool PERM = true; const bf16* gate; const bf16* prev; bf16* out;
    __device__ __forceinline__ void operator()(const f32x4 (&acc)[2][2][4][2], const Unit& u, int wr, int wc, int fr, int fq) const {
        const int row0 = u.pm * BM + wr * 64 + fr, col0 = u.pn * BM + wc * 32 + 8 * fq;
#pragma unroll
        for (int ai = 0; ai < 2; ++ai)
#pragma unroll
            for (int m = 0; m < 4; ++m) { const size_t ro = (size_t)(row0 + ai * HALF + m * 16) * D + col0;
#pragma unroll
                for (int bj = 0; bj < 2; ++bj) { const f32x4 v0 = acc[ai][bj][m][0], v1 = acc[ai][bj][m][1];
                    const v4u g = *(const v4u*)(gate + ro + bj * HALF); v4u pv = (v4u){0u, 0u, 0u, 0u}; if (ADD) pv = *(const v4u*)(prev + ro + bj * HALF);
                    v4u w;
                    w.x = cvt_pk_bf16(bflo(pv.x) + bflo(g.x) * v0[0], bfhi(pv.x) + bfhi(g.x) * v0[1]); w.y = cvt_pk_bf16(bflo(pv.y) + bflo(g.y) * v0[2], bfhi(pv.y) + bfhi(g.y) * v0[3]);
                    w.z = cvt_pk_bf16(bflo(pv.z) + bflo(g.z) * v1[0], bfhi(pv.z) + bfhi(g.z) * v1[1]); w.w = cvt_pk_bf16(bflo(pv.w) + bflo(g.w) * v1[2], bfhi(pv.w) + bfhi(g.w) * v1[3]);
                    *(v4u*)(out + ro + bj * HALF) = w; } }
    }
};
struct EpiResF32 {
    static constexpr bool PERM = false; const float* res; float* out;
    __device__ __forceinline__ void operator()(const f32x4 (&acc)[2][2][4][2], const Unit& u, int wr, int wc, int fr, int fq) const {
        const int row0 = u.pm * BM + wr * 64 + fr, col0 = u.pn * BM + wc * 32 + 4 * fq;
#pragma unroll
        for (int ai = 0; ai < 2; ++ai)
#pragma unroll
            for (int m = 0; m < 4; ++m) { const size_t ro = (size_t)(row0 + ai * HALF + m * 16) * D + col0;
#pragma unroll
                for (int bj = 0; bj < 2; ++bj)
#pragma unroll
                    for (int n = 0; n < 2; ++n) { const size_t o = ro + bj * HALF + n * 16; *(f32x4*)(out + o) = *(const f32x4*)(res + o) + acc[ai][bj][m][n]; } }
    }
};
constexpr int MOE_TP = LDSCTL_OFF + 512, MOE_CNT = LDSCTL_OFF + 640, MOE_OFF = LDSCTL_OFF + 704, MOE_IDX = LDSCTL_OFF + 1024;
struct MoeSched {
    const LAS int* tp; const LAS int* cntp; const LAS int* offp; const LAS int* idx; int G, c, K; const char* A; const char* Bt; size_t bstride; bool gather;
    __device__ __forceinline__ bool next(int i, Unit& u) const {
        const int L = i * G + c, tile = L >> 2; if (tile >= tp[16]) return false;
        int e = 0;
#pragma unroll
        for (int k = 1; k < 16; ++k) e += (tile >= tp[k]) ? 1 : 0;
        u.e = e; u.pm = tile - tp[e]; u.pn = L & 3; u.cnt = cntp[e]; u.off = offp[e]; u.slot = i; return true;
    }
    __device__ __forceinline__ const char* a_base(const Unit& u) const { return gather ? A : A + (size_t)(u.off + u.pm * BM) * K * 2; }
    __device__ __forceinline__ const char* b_base(const Unit& u) const { return Bt + (size_t)u.e * bstride + (size_t)u.pn * BM * K * 2; }
    __device__ __forceinline__ void a_offsets(const Unit& u, const int (&RA)[2], const int (&CA)[2], unsigned (&v)[2][2]) const {
#pragma unroll
        for (int h = 0; h < 2; ++h)
#pragma unroll
            for (int i = 0; i < 2; ++i) { const int row = gather ? idx[u.slot * 256 + h * HALF + RA[i]] : h * HALF + RA[i]; v[h][i] = (unsigned)(row * K + CA[i]) * 2u; } }
};
struct EpiMoe1 {
    static constexpr bool PERM = true; bf16* hdn;
    __device__ __forceinline__ void operator()(const f32x4 (&acc)[2][2][4][2], const Unit& u, int wr, int wc, int fr, int fq) const {
        const int row0 = u.off + u.pm * BM + wr * 64 + fr, col0 = u.pn * HALF + wc * 32 + 8 * fq;
#pragma unroll
        for (int ai = 0; ai < 2; ++ai)
#pragma unroll
            for (int m = 0; m < 4; ++m) { float h[8];
#pragma unroll
                for (int n = 0; n < 2; ++n)
#pragma unroll
                    for (int i = 0; i < 4; ++i) { const float g = acc[ai][0][m][n][i], up = acc[ai][1][m][n][i]; h[4 * n + i] = g * __builtin_amdgcn_rcpf(1.f + __builtin_amdgcn_exp2f(-LOG2E * g)) * up; }
                v4u w; w.x = cvt_pk_bf16(h[0], h[1]); w.y = cvt_pk_bf16(h[2], h[3]); w.z = cvt_pk_bf16(h[4], h[5]); w.w = cvt_pk_bf16(h[6], h[7]);
                *(v4u*)(hdn + (size_t)(row0 + ai * HALF + m * 16) * FF + col0) = w; }
    }
};
struct EpiMoe2 {
    static constexpr bool PERM = true; const unsigned* list; const float* wlist; bf16* y;
    __device__ __forceinline__ void operator()(const f32x4 (&acc)[2][2][4][2], const Unit& u, int wr, int wc, int fr, int fq) const {
        const int r0 = u.pm * BM + wr * 64 + fr, col0 = u.pn * BM + wc * 32 + 8 * fq;
#pragma unroll
        for (int ai = 0; ai < 2; ++ai)
#pragma unroll
            for (int m = 0; m < 4; ++m) { const int ii = r0 + ai * HALF + m * 16;
                if (ii < u.cnt) { const unsigned le = list[u.e * MREAL + ii]; const float w = wlist[u.e * MREAL + ii];
                    bf16* rowp = y + ((size_t)(le >> 14) * MREAL + (le & 0x3fffu)) * D + col0;
#pragma unroll
                    for (int bj = 0; bj < 2; ++bj) { const f32x4 v0 = acc[ai][bj][m][0] * w, v1 = acc[ai][bj][m][1] * w; v4u o;
                        o.x = cvt_pk_bf16(v0[0], v0[1]); o.y = cvt_pk_bf16(v0[2], v0[3]); o.z = cvt_pk_bf16(v1[0], v1[1]); o.w = cvt_pk_bf16(v1[2], v1[3]);
                        *(v4u*)(rowp + bj * HALF) = o; } } }
    }
};
}

__device__ __forceinline__ void p1_fast(Frame& F, const Args& A) {
    pg8::StaticOrder S; S.init((const bf16*)(F.ws + WS_XN), (const bf16*)(F.ws + WS_WIN), MPAD, INW, D, F.G, (int)blockIdx.x);
    pg8::EpiZ E{F.ws};
    pg8::gemm_phase<pg8::EpiZ, pg8::StaticOrder, true>(F.lds, D, S, E);
}
__device__ __forceinline__ void merge_fast(Frame& F, const Args& A) {
    { pg8::StaticOrder S; S.init((const bf16*)(F.ws + WS_Q), (const bf16*)(F.ws + WS_WATT), MREAL, D, D, F.G, (int)blockIdx.x);
      pg8::EpiGate<false> E{(const bf16*)(F.ws + WS_GA), nullptr, (bf16*)(F.ws + WS_XR)};
      pg8::gemm_phase<pg8::EpiGate<false>, pg8::StaticOrder, false>(F.lds, D, S, E); }
    VM_WAIT(); __builtin_amdgcn_fence(__ATOMIC_ACQUIRE, "agent"); VM_WAIT(); __syncthreads();
    { pg8::StaticOrder S; S.init((const bf16*)(F.ws + WS_GY), (const bf16*)(F.ws + WS_WREC), MREAL, D, D, F.G, (int)blockIdx.x);
      pg8::EpiGate<true> E{(const bf16*)(F.ws + WS_GR), (const bf16*)(F.ws + WS_XR), (bf16*)(F.ws + WS_XR)};
      pg8::gemm_phase<pg8::EpiGate<true>, pg8::StaticOrder, false>(F.lds, D, S, E); }
}
__device__ __forceinline__ void wout_fast(Frame& F, const Args& A) {
    pg8::StaticOrder S; S.init((const bf16*)(F.ws + WS_XR), (const bf16*)(F.ws + WS_WOUT), MREAL, D, D, F.G, (int)blockIdx.x);
    pg8::EpiResF32 E{A.in[I_X], F.out};
    pg8::gemm_phase<pg8::EpiResF32, pg8::StaticOrder, false>(F.lds, D, S, E);
}
__device__ __forceinline__ void moe_tables(Frame& F) {
    LAS int* tp = (LAS int*)(F.lds + pg8::MOE_TP); LAS int* cp = (LAS int*)(F.lds + pg8::MOE_CNT); LAS int* op = (LAS int*)(F.lds + pg8::MOE_OFF);
    if (F.tid == 0) { int t = 0, o = 0;
        for (int e = 0; e < NEXP; ++e) { const int cnt = (int)__hip_atomic_load(F.ctl + CW_CNT + 64 * e, RLX_AGENT); tp[e] = t; cp[e] = cnt; op[e] = o; t += (cnt + 255) >> 8; o += (cnt + 255) & ~255; }
        tp[16] = t; }
    __syncthreads();
}
__device__ __forceinline__ void moe1_fast(Frame& F, const Args& A) {
    moe_tables(F);
    pg8::MoeSched S{(const LAS int*)(F.lds + pg8::MOE_TP), (const LAS int*)(F.lds + pg8::MOE_CNT), (const LAS int*)(F.lds + pg8::MOE_OFF), (const LAS int*)(F.lds + pg8::MOE_IDX),
                    F.G, (int)blockIdx.x, D, (const char*)(F.ws + WS_Q), (const char*)(F.ws + WS_WGU), (size_t)1024 * 1024 * 2, true};
    { const unsigned* LIST = (const unsigned*)(F.ws + WS_LIST); LAS int* idx = (LAS int*)(F.lds + pg8::MOE_IDX); pg8::Unit u;
      for (int i = 0; i < 8 && S.next(i, u); ++i) if (F.tid < 256) { const int ii = u.pm * 256 + F.tid; idx[i * 256 + F.tid] = (int)(LIST[u.e * MREAL + (ii < u.cnt ? ii : 0)] & 0x3fffu); }
      __syncthreads(); }
    pg8::EpiMoe1 E{(bf16*)(F.ws + WS_XR)};
    pg8::gemm_phase<pg8::EpiMoe1, pg8::MoeSched, true>(F.lds, D, S, E);
}
__device__ __forceinline__ void moe2_fast(Frame& F, const Args& A) {
    moe_tables(F);
    pg8::MoeSched S{(const LAS int*)(F.lds + pg8::MOE_TP), (const LAS int*)(F.lds + pg8::MOE_CNT), (const LAS int*)(F.lds + pg8::MOE_OFF), (const LAS int*)(F.lds + pg8::MOE_IDX),
                    F.G, (int)blockIdx.x, FF, (const char*)(F.ws + WS_XR), (const char*)(F.ws + WS_WD), (size_t)1024 * 512 * 2, false};
    pg8::EpiMoe2 E{(const unsigned*)(F.ws + WS_LIST), (const float*)(F.ws + WS_WLIST), (bf16*)(F.ws + WS_GA)};
    pg8::gemm_phase<pg8::EpiMoe2, pg8::MoeSched, true>(F.lds, FF, S, E);
}


namespace scan {
constexpr int XC_OFF = 0, OUT_OFF = 65536, NCH = SEQ / 256, NSUM = NCH + 1;
typedef __attribute__((address_space(3))) const unsigned char* lcp;
template <int CTRL> __device__ __forceinline__ float dppf(float old, float v) {
    return __builtin_bit_cast(float, __builtin_amdgcn_update_dpp(__builtin_bit_cast(int, old), __builtin_bit_cast(int, v), CTRL, 0xf, 0xf, false)); }
template <int PAT> __device__ __forceinline__ float swz(float v) { return __builtin_bit_cast(float, __builtin_amdgcn_ds_swizzle(__builtin_bit_cast(int, v), PAT)); }
template <int DIR> __device__ __forceinline__ void scan_local(lcp xc, int jt, const bf16x8 (&wf)[2][4], const f32x4 (&bias)[2], const f32x4 c2, f32x4& P, f32x4& H, f32x4& lsum, int w, int fr, int fq) {
    lcp rp = xc + (16 * jt + fr) * 256;
    f32x4 ar = bias[0], ai = bias[1];
#pragma unroll
    for (int ks = 0; ks < 4; ++ks) { const bf16x8 bfr = *(const LAS bf16x8*)(rp + (((4 * ks + fq) ^ fr) << 4));
        ar = __builtin_amdgcn_mfma_f32_16x16x32_bf16(wf[0][ks], bfr, ar, 0, 0, 0);
        ai = __builtin_amdgcn_mfma_f32_16x16x32_bf16(wf[1][ks], bfr, ai, 0, 0, 0); }
    const v2u xw = *(const LAS v2u*)(rp + (((2 * w + (fq >> 1)) ^ fr) << 4) + (fq & 1) * 8);
    const float xv[4] = {bflo(xw.x), bfhi(xw.x), bflo(xw.y), bfhi(xw.y)};
#pragma unroll
    for (int r = 0; r < 4; ++r) {
        const float rg = __builtin_amdgcn_rcpf(1.f + __builtin_amdgcn_exp2f(ar[r])), ig = __builtin_amdgcn_rcpf(1.f + __builtin_amdgcn_exp2f(ai[r]));
        const float la = c2[r] * rg, a = __builtin_amdgcn_exp2f(la);
        P[r] = a; H[r] = __builtin_amdgcn_sqrtf(fmaf(-a, a, 1.f)) * (ig * xv[r]); lsum[r] += la; }
#define SCAN_STEP(dd) do { _Pragma("unroll") for (int r = 0; r < 4; ++r) { \
        const float Hs = dppf<(DIR ? 0x100 : 0x110) + dd>(0.f, H[r]), Ps = dppf<(DIR ? 0x100 : 0x110) + dd>(1.f, P[r]); H[r] = fmaf(P[r], Hs, H[r]); P[r] *= Ps; } } while (0)
    SCAN_STEP(1); SCAN_STEP(2); SCAN_STEP(4); SCAN_STEP(8);
#undef SCAN_STEP
}
template <int DIR> __device__ __forceinline__ f32x4 scan_apply(const f32x4 P, const f32x4 H, f32x4& carry) {
    f32x4 h;
#pragma unroll
    for (int r = 0; r < 4; ++r) { h[r] = fmaf(P[r], carry[r], H[r]); carry[r] = swz<DIR ? 0x010 : 0x1F0>(h[r]); }
    return h;
}
template <int DIR> __device__ __forceinline__ void scan_group4(lcp xc, int g, const bf16x8 (&wf)[2][4], const f32x4 (&bias)[2], const f32x4 c2, f32x4& carry, f32x4& lsum, int w, int fr, int fq, f32x4 (&h)[4]) {
    f32x4 P[4], H[4];
#pragma unroll
    for (int i = 0; i < 4; ++i) scan_local<DIR>(xc, DIR ? 4 * g + 3 - i : 4 * g + i, wf, bias, c2, P[i], H[i], lsum, w, fr, fq);
#pragma unroll
    for (int i = 0; i < 4; ++i) h[i] = scan_apply<DIR>(P[i], H[i], carry);
    __builtin_amdgcn_sched_barrier(0);
}
template <int DIR> __device__ __forceinline__ void scan_consts(Frame& F, const Args& A, int n, int w, int fr, int fq, bf16x8 (&wf)[2][4], f32x4 (&bias)[2], f32x4& c2) {
    const bf16* WL = (const bf16*)(F.ws + WS_WLRU) + (size_t)n * 512 * 128;
#pragma unroll
    for (int g = 0; g < 2; ++g)
#pragma unroll
        for (int ks = 0; ks < 4; ++ks) wf[g][ks] = *(const bf16x8*)(WL + (size_t)((DIR * 2 + g) * 128 + 16 * w + fr) * 128 + 32 * ks + 8 * fq);
    const int ch0 = 128 * n + 16 * w + 4 * fq;
    bias[0] = *(const f32x4*)(A.in[I_LBA] + DIR * D + ch0) * (-LOG2E); bias[1] = *(const f32x4*)(A.in[I_LBX] + DIR * D + ch0) * (-LOG2E);
    const f32x4 lam = *(const f32x4*)(A.in[I_LAM] + DIR * D + ch0);
#pragma unroll
    for (int r = 0; r < 4; ++r) c2[r] = -8.f * LOG2E * log1pf(__expf(-lam[r]));
}
template <bool FINAL> __device__ __forceinline__ void scan_unit(Frame& F, const Args& A, int b, int n, int c  , bool dry = false) {
    const int tid = F.tid, lane = F.lane, w = F.wave, fr = lane & 15, fq = lane >> 4;
    const int NT = c < 0 ? 1 : 16, t0 = c < 0 ? 0 : NMETA + 256 * c;
    const bf16* XR = (const bf16*)(F.ws + WS_XR);
    LAS unsigned char* lds = F.lds;
    {
        const int q = tid & 15, gc = 128 * n + 8 * q;
        float cw[4][8], cbv[8];
#pragma unroll
        for (int i = 0; i < 8; ++i) { cbv[i] = A.in[I_CONVB][gc + i];
#pragma unroll
            for (int j = 0; j < 4; ++j) cw[j][i] = A.in[I_CONVW][j * D + gc + i]; }
        for (int tt = tid >> 4; tt < 16 * NT; tt += 32) { const int t = t0 + tt;
            float a8[8];
#pragma unroll
            for (int i = 0; i < 8; ++i) a8[i] = cbv[i];
#pragma unroll
            for (int j = 0; j < 4; ++j) { const int ts = t - 2 + j;
                if (ts >= 0 && ts < TLEN) { const v4u x = *(const v4u*)(XR + (size_t)trow(b, ts) * D + gc);
                    a8[0] += cw[j][0] * bflo(x.x); a8[1] += cw[j][1] * bfhi(x.x); a8[2] += cw[j][2] * bflo(x.y); a8[3] += cw[j][3] * bfhi(x.y);
                    a8[4] += cw[j][4] * bflo(x.z); a8[5] += cw[j][5] * bfhi(x.z); a8[6] += cw[j][6] * bflo(x.w); a8[7] += cw[j][7] * bfhi(x.w); } }
            v4u o; o.x = pg8::cvt_pk_bf16(a8[0], a8[1]); o.y = pg8::cvt_pk_bf16(a8[2], a8[3]); o.z = pg8::cvt_pk_bf16(a8[4], a8[5]); o.w = pg8::cvt_pk_bf16(a8[6], a8[7]);
            *(LAS v4u*)(lds + XC_OFF + tt * 256 + ((q ^ (tt & 15)) << 4)) = o; }
    }
    __syncthreads();
    const int ch0 = 128 * n + 16 * w + 4 * fq;
    float* SUMP = (float*)(F.ws + WS_SUM); float* SUMH = SUMP + 2 * 2 * NSUM * D;
    lcp xc = (lcp)(lds + XC_OFF);
    bf16x8 wf[2][4]; f32x4 bias[2], c2;
    if constexpr (!FINAL) {
        {   f32x4 cf = (f32x4){0.f, 0.f, 0.f, 0.f}, lf = cf;
            scan_consts<0>(F, A, n, w, fr, fq, wf, bias, c2);
            if (NT == 1) { f32x4 P, H; scan_local<0>(xc, 0, wf, bias, c2, P, H, lf, w, fr, fq); (void)scan_apply<0>(P, H, cf); }
            else for (int g = 0; g < 4; ++g) { f32x4 h4[4]; scan_group4<0>(xc, g, wf, bias, c2, cf, lf, w, fr, fq, h4); }
#pragma unroll
            for (int r = 0; r < 4; ++r) {
#pragma unroll
                for (int o = 1; o < 16; o <<= 1) lf[r] += __shfl_xor(lf[r], o);
                lf[r] = __builtin_amdgcn_exp2f(lf[r]); }
            if (fr == 0) { const size_t o0 = ((size_t)(0 * 2 + b) * NSUM + (c + 1)) * D + ch0; *(f32x4*)(SUMP + o0) = lf; *(f32x4*)(SUMH + o0) = cf; } }
        if (c >= 0) { f32x4 cb = (f32x4){0.f, 0.f, 0.f, 0.f}, lb = cb;
            scan_consts<1>(F, A, n, w, fr, fq, wf, bias, c2);
            for (int g = 3; g >= 0; --g) { f32x4 h4[4]; scan_group4<1>(xc, g, wf, bias, c2, cb, lb, w, fr, fq, h4); }
#pragma unroll
            for (int r = 0; r < 4; ++r) {
#pragma unroll
                for (int o = 1; o < 16; o <<= 1) lb[r] += __shfl_xor(lb[r], o);
                lb[r] = __builtin_amdgcn_exp2f(lb[r]); }
            if (fr == 0) { const size_t o1 = ((size_t)(1 * 2 + b) * NSUM + (c + 1)) * D + ch0; *(f32x4*)(SUMP + o1) = lb; *(f32x4*)(SUMH + o1) = cb; } }
        __syncthreads();
    } else {
        f32x4 cf = (f32x4){0.f, 0.f, 0.f, 0.f}, cb = cf, ls = cf;
        {   const int jA = fr, jB = 16 + fr;
            const size_t oA = ((size_t)(0 * 2 + b) * NSUM + jA) * D + ch0, oB = ((size_t)(0 * 2 + b) * NSUM + jB) * D + ch0;
            const size_t qA = ((size_t)(1 * 2 + b) * NSUM + jA) * D + ch0, qB = ((size_t)(1 * 2 + b) * NSUM + jB) * D + ch0, q32 = ((size_t)(1 * 2 + b) * NSUM + 32) * D + ch0;
            const f32x4 one = (f32x4){1.f, 1.f, 1.f, 1.f}, zero = (f32x4){0.f, 0.f, 0.f, 0.f};
            f32x4 PA = *(const f32x4*)(SUMP + oA), HA = *(const f32x4*)(SUMH + oA), PB = *(const f32x4*)(SUMP + oB), HB = *(const f32x4*)(SUMH + oB);
            f32x4 RA = *(const f32x4*)(SUMP + qA), GA_ = *(const f32x4*)(SUMH + qA), RB = *(const f32x4*)(SUMP + qB), GB_ = *(const f32x4*)(SUMH + qB), G32 = *(const f32x4*)(SUMH + q32);
            if (jA > c) { PA = one; HA = zero; } if (jB > c) { PB = one; HB = zero; }
            if (jA < c + 2) { RA = one; GA_ = zero; } if (jB < c + 2) { RB = one; GB_ = zero; } if (32 < c + 2) G32 = zero;
#define FOLD(P_, H_, CTRL) do { _Pragma("unroll") for (int r = 0; r < 4; ++r) { const float Hs = dppf<CTRL>(0.f, H_[r]), Ps = dppf<CTRL>(1.f, P_[r]); H_[r] = fmaf(P_[r], Hs, H_[r]); P_[r] *= Ps; } } while (0)
            FOLD(PA, HA, 0x111); FOLD(PA, HA, 0x112); FOLD(PA, HA, 0x114); FOLD(PA, HA, 0x118); FOLD(PB, HB, 0x111); FOLD(PB, HB, 0x112); FOLD(PB, HB, 0x114); FOLD(PB, HB, 0x118);
            FOLD(RA, GA_, 0x101); FOLD(RA, GA_, 0x102); FOLD(RA, GA_, 0x104); FOLD(RA, GA_, 0x108); FOLD(RB, GB_, 0x101); FOLD(RB, GB_, 0x102); FOLD(RB, GB_, 0x104); FOLD(RB, GB_, 0x108);
#undef FOLD
#pragma unroll
            for (int r = 0; r < 4; ++r) {
                const float hA = swz<0x1F0>(HA[r]), pB = swz<0x1F0>(PB[r]), hB = swz<0x1F0>(HB[r]); cf[r] = fmaf(pB, hA, hB);
                const float pBb = swz<0x010>(RB[r]), hBb = swz<0x010>(GB_[r]), pAb = swz<0x010>(RA[r]), hAb = swz<0x010>(GA_[r]);
                cb[r] = fmaf(pAb, fmaf(pBb, G32[r], hBb), hAb); }
        }
        f32x4 hfb[16];
        scan_consts<0>(F, A, n, w, fr, fq, wf, bias, c2);
#pragma unroll
        for (int g = 0; g < 4; ++g) { f32x4 h4[4]; scan_group4<0>(xc, g, wf, bias, c2, cf, ls, w, fr, fq, h4);
#pragma unroll
            for (int i = 0; i < 4; ++i) hfb[4 * g + i] = h4[i]; }
        scan_consts<1>(F, A, n, w, fr, fq, wf, bias, c2);
#pragma unroll
        for (int g = 3; g >= 0; --g) { f32x4 h4[4]; scan_group4<1>(xc, g, wf, bias, c2, cb, ls, w, fr, fq, h4);
#pragma unroll
            for (int i = 0; i < 4; ++i) { const int j = 4 * g + 3 - i; const f32x4 v_ = hfb[j] + h4[i];
                v2u o_; o_.x = pg8::cvt_pk_bf16(v_[0], v_[1]); o_.y = pg8::cvt_pk_bf16(v_[2], v_[3]);
                *(LAS v2u*)(lds + OUT_OFF + (16 * j + fr) * 256 + (((2 * w + (fq >> 1)) ^ fr) << 4) + (fq & 1) * 8) = o_; } }
        __syncthreads();
        bf16* GY = (bf16*)(F.ws + WS_GY);
        const int q = tid & 15;
        for (int tt = tid >> 4; tt < 256; tt += 32) {
            const v4u hv = *(const LAS v4u*)(lds + OUT_OFF + tt * 256 + ((q ^ (tt & 15)) << 4));
            bf16* gp = GY + (size_t)(b * SEQ + 256 * c + tt) * D + 128 * n + 8 * q; const v4u g = *(const v4u*)gp; v4u o;
            o.x = pg8::cvt_pk_bf16(bflo(hv.x) * bflo(g.x), bfhi(hv.x) * bfhi(g.x)); o.y = pg8::cvt_pk_bf16(bflo(hv.y) * bflo(g.y), bfhi(hv.y) * bfhi(g.y));
            o.z = pg8::cvt_pk_bf16(bflo(hv.z) * bflo(g.z), bfhi(hv.z) * bfhi(g.z)); o.w = pg8::cvt_pk_bf16(bflo(hv.w) * bflo(g.w), bfhi(hv.w) * bfhi(g.w));
            *(v4u*)(dry ? (bf16*)F.out + (gp - GY) : gp) = o; }
        __syncthreads();
    }
}
template <bool FINAL> __device__ __forceinline__ void scan_phase(Frame& F, const Args& A, bool dry = false) {
    constexpr int NU = BATCH * 8 * NCH;
    for (int it = F.vcu; it < NU; it += F.G) { const int b = it / (8 * NCH), r = it % (8 * NCH), ci = r / 8, n = r % 8;
        for (int c = (!FINAL && ci == 0) ? -1 : ci; c <= ci; ++c) scan_unit<FINAL>(F, A, b, n, c, dry); }
}
}


namespace scan2 {
typedef float f32x16 __attribute__((ext_vector_type(16)));
typedef __attribute__((address_space(3))) const unsigned char* lcp;
constexpr int XC_OFF = 0, OUT_OFF = 65536, XCH_OFF = LDSCTL_OFF + 1024, NCH = SEQ / 256, NSUM = NCH + 1;
struct Consts { bf16x8 wf[2][8]; float br, bi, c2; };
__device__ __forceinline__ void load_consts(Frame& F, const Args& A, int DIR, int n, int cg, int r32, int hi, Consts& C) {
    const bf16* WL = (const bf16*)(F.ws + WS_WLRU) + (size_t)n * 512 * 128;
#pragma unroll
    for (int g = 0; g < 2; ++g)
#pragma unroll
        for (int ks = 0; ks < 8; ++ks) C.wf[g][ks] = *(const bf16x8*)(WL + (size_t)((DIR * 2 + g) * 128 + 32 * cg + r32) * 128 + 16 * ks + 8 * hi);
    const int ch = 128 * n + 32 * cg + r32;
    C.br = A.in[I_LBA][DIR * D + ch] * (-LOG2E); C.bi = A.in[I_LBX][DIR * D + ch] * (-LOG2E);
    C.c2 = -8.f * LOG2E * log1pf(__expf(-A.in[I_LAM][DIR * D + ch]));
}
__device__ __forceinline__ void both_halves(float v, float& lo, float& hi_) { auto rr = __builtin_amdgcn_permlane32_swap(__float_as_uint(v), __float_as_uint(v), false, false); lo = __uint_as_float(rr[0]); hi_ = __uint_as_float(rr[1]); }
struct Addr { lcp ca[8]; lcp cx[2]; };
template <int DIR> __device__ __forceinline__ void tile_local(const Addr& AD, int T, const Consts& C, const bf16x8 (&ident)[2], f32x16& P, f32x16& H, float& lsum, bool meta16) {
    const int toff = T * 8192;
    {   f32x16 ar;
#pragma unroll
        for (int r = 0; r < 16; ++r) ar[r] = C.br;
#pragma unroll
        for (int ks = 0; ks < 8; ++ks) { const bf16x8 afr = *(const LAS bf16x8*)(AD.ca[ks] + toff); ar = __builtin_amdgcn_mfma_f32_32x32x16_bf16(afr, C.wf[0][ks], ar, 0, 0, 0); }
#pragma unroll
        for (int r = 0; r < 16; ++r) { const float rg = __builtin_amdgcn_rcpf(1.f + __builtin_amdgcn_exp2f(ar[r])); float la = C.c2 * rg; if (meta16 && r >= 8) la = 0.f; lsum += la; P[r] = __builtin_amdgcn_exp2f(la); } }
    {   f32x16 ai, ax = {};
#pragma unroll
        for (int r = 0; r < 16; ++r) ai[r] = C.bi;
#pragma unroll
        for (int ks = 0; ks < 8; ++ks) { const bf16x8 afr = *(const LAS bf16x8*)(AD.ca[ks] + toff); ai = __builtin_amdgcn_mfma_f32_32x32x16_bf16(afr, C.wf[1][ks], ai, 0, 0, 0); }
#pragma unroll
        for (int q = 0; q < 2; ++q) { const bf16x8 afr = *(const LAS bf16x8*)(AD.cx[q] + toff); ax = __builtin_amdgcn_mfma_f32_32x32x16_bf16(afr, ident[q], ax, 0, 0, 0); }
#pragma unroll
        for (int r = 0; r < 16; ++r) { const float ig = __builtin_amdgcn_rcpf(1.f + __builtin_amdgcn_exp2f(ai[r])); const float a = P[r];
            H[r] = (meta16 && r >= 8) ? 0.f : __builtin_amdgcn_sqrtf(fmaf(-a, a, 1.f)) * (ig * ax[r]); } }
#pragma unroll
    for (int k = 0; k < 4; ++k) {
        if (DIR == 0) {
#pragma unroll
            for (int p_ = 1; p_ < 4; ++p_) { const int i = 4 * k + p_; H[i] = fmaf(P[i], H[i - 1], H[i]); P[i] *= P[i - 1]; } }
        else {
#pragma unroll
            for (int p_ = 2; p_ >= 0; --p_) { const int i = 4 * k + p_; H[i] = fmaf(P[i], H[i + 1], H[i]); P[i] *= P[i + 1]; } } }
}
template <int DIR> __device__ __forceinline__ void tile_chain(const f32x16& P, const f32x16& H, int hi, float& carry, f32x16& h) {
    float cr[4], s = carry;
#pragma unroll
    for (int kk = 0; kk < 4; ++kk) { const int k = DIR ? 3 - kk : kk, e = DIR ? 4 * k : 4 * k + 3;
        float plo, phi, hlo, hhi; both_halves(P[e], plo, phi); both_halves(H[e], hlo, hhi);
        if (DIR == 0) { const float sm = fmaf(plo, s, hlo); cr[k] = hi ? sm : s; s = fmaf(phi, sm, hhi); }
        else { const float sm = fmaf(phi, s, hhi); cr[k] = hi ? s : sm; s = fmaf(plo, sm, hlo); } }
    carry = s;
#pragma unroll
    for (int r = 0; r < 16; ++r) h[r] = fmaf(P[r], cr[r >> 2], H[r]);
}
template <bool FINAL> __device__ __forceinline__ void scan_unit(Frame& F, const Args& A, int b, int n, int c, bool dry) {
    int tid = F.tid; asm volatile("" : "+v"(tid));
    const int lane = tid & 63, w = __builtin_amdgcn_readfirstlane(tid >> 6), r32 = lane & 31, hi = lane >> 5, cg = w & 3, th = w >> 2;
    const int NTT = c < 0 ? 1 : 8, t0 = c < 0 ? 0 : NMETA + 256 * c;
    const bf16* XR = (const bf16*)(F.ws + WS_XR);
    LAS unsigned char* lds = F.lds;
    {
        const int q = tid & 15, gc = 128 * n + 8 * q;
        float cw[4][8], cbv[8];
#pragma unroll
        for (int i = 0; i < 8; ++i) { cbv[i] = A.in[I_CONVB][gc + i];
#pragma unroll
            for (int j = 0; j < 4; ++j) cw[j][i] = A.in[I_CONVW][j * D + gc + i]; }
#pragma unroll 1
        for (int ib = 0; ib < 8; ib += 4) {
#pragma unroll
        for (int it = ib; it < ib + 4; ++it) { const int tt = (tid >> 4) + 32 * it; if (tt < 32 * NTT) { const int t = t0 + tt;
            v4u x[4];
#pragma unroll
            for (int j = 0; j < 4; ++j) { const int ts = t - 2 + j; const bool ok = ts >= 0 && ts < TLEN; x[j] = *(const v4u*)(XR + (size_t)trow(b, ok ? ts : t) * D + gc); if (!ok) x[j] = (v4u){0u, 0u, 0u, 0u}; }
            float a8[8];
#pragma unroll
            for (int i = 0; i < 8; ++i) a8[i] = cbv[i];
#pragma unroll
            for (int j = 0; j < 4; ++j) {
                a8[0] += cw[j][0] * bflo(x[j].x); a8[1] += cw[j][1] * bfhi(x[j].x); a8[2] += cw[j][2] * bflo(x[j].y); a8[3] += cw[j][3] * bfhi(x[j].y);
                a8[4] += cw[j][4] * bflo(x[j].z); a8[5] += cw[j][5] * bfhi(x[j].z); a8[6] += cw[j][6] * bflo(x[j].w); a8[7] += cw[j][7] * bfhi(x[j].w); }
            v4u o; o.x = pg8::cvt_pk_bf16(a8[0], a8[1]); o.y = pg8::cvt_pk_bf16(a8[2], a8[3]); o.z = pg8::cvt_pk_bf16(a8[4], a8[5]); o.w = pg8::cvt_pk_bf16(a8[6], a8[7]);
            *(LAS v4u*)(lds + XC_OFF + tt * 256 + ((q ^ (tt & 15)) << 4)) = o; } }
        __builtin_amdgcn_sched_barrier(0); }
    }
    __syncthreads();
    bf16x8 ident[2];
#pragma unroll
    for (int q = 0; q < 2; ++q)
#pragma unroll
        for (int j = 0; j < 8; ++j) ident[q][j] = (r32 == 16 * q + 8 * hi + j) ? (short)0x3F80 : (short)0;
    Addr AD;
    { lcp rb = (lcp)(lds + XC_OFF) + (c < 0 ? 0 : th * 32768) + r32 * 256; const int sw = r32 & 15;
#pragma unroll
      for (int ks = 0; ks < 8; ++ks) AD.ca[ks] = rb + (((2 * ks + hi) ^ sw) << 4);
#pragma unroll
      for (int q = 0; q < 2; ++q) AD.cx[q] = rb + (((2 * (2 * cg + q) + hi) ^ sw) << 4); }
    const int ch = 128 * n + 32 * cg + r32;
    float* SUMP = (float*)(F.ws + WS_SUM); float* SUMH = SUMP + 2 * 2 * NSUM * D;
    LAS float* xch = (LAS float*)(lds + XCH_OFF);
    lcp xc = (lcp)(lds + XC_OFF);
    const int T0 = 4 * th;
    if constexpr (!FINAL) {
        float Pf = 1.f, Hf = 0.f, Pb = 1.f, Hb = 0.f;
        if (c < 0) { if (th == 0) { Consts C; load_consts(F, A, 0, n, cg, r32, hi, C); f32x16 P, H, h; float ls = 0.f, s = 0.f;
                tile_local<0>(AD, 0, C, ident, P, H, ls, true); tile_chain<0>(P, H, hi, s, h);
                float l0, l1; both_halves(ls, l0, l1); Pf = __builtin_amdgcn_exp2f(l0 + l1); Hf = s; asm volatile("" :: "v"(h[0]));
                if (hi == 0) { const size_t o0 = ((size_t)(0 * 2 + b) * NSUM + 0) * D + ch; SUMP[o0] = Pf; SUMH[o0] = Hf; } } }
        else {
            { Consts C; load_consts(F, A, 0, n, cg, r32, hi, C); float ls = 0.f, s = 0.f;
#pragma unroll
              for (int i = 0; i < 4; ++i) { f32x16 P, H, h; tile_local<0>(AD, i, C, ident, P, H, ls, false); tile_chain<0>(P, H, hi, s, h); asm volatile("" :: "v"(h[0])); }
              float l0, l1; both_halves(ls, l0, l1); Pf = __builtin_amdgcn_exp2f(l0 + l1); Hf = s; }
            { Consts C; load_consts(F, A, 1, n, cg, r32, hi, C); float ls = 0.f, s = 0.f;
#pragma unroll
              for (int i = 3; i >= 0; --i) { f32x16 P, H, h; tile_local<1>(AD, i, C, ident, P, H, ls, false); tile_chain<1>(P, H, hi, s, h); asm volatile("" :: "v"(h[0])); }
              float l0, l1; both_halves(ls, l0, l1); Pb = __builtin_amdgcn_exp2f(l0 + l1); Hb = s; }
            if (th == 1 && hi == 0) { xch[(2 * 4 + cg) * 32 + r32] = Pf; xch[(3 * 4 + cg) * 32 + r32] = Hf; xch[(4 * 4 + cg) * 32 + r32] = Pb; xch[(5 * 4 + cg) * 32 + r32] = Hb; }
            __syncthreads();
            if (th == 0 && hi == 0) { const float Pf1 = xch[(2 * 4 + cg) * 32 + r32], Hf1 = xch[(3 * 4 + cg) * 32 + r32], Pb1 = xch[(4 * 4 + cg) * 32 + r32], Hb1 = xch[(5 * 4 + cg) * 32 + r32];
                const size_t o0 = ((size_t)(0 * 2 + b) * NSUM + (c + 1)) * D + ch, o1 = ((size_t)(1 * 2 + b) * NSUM + (c + 1)) * D + ch;
                SUMP[o0] = Pf * Pf1; SUMH[o0] = fmaf(Pf1, Hf, Hf1); SUMP[o1] = Pb * Pb1; SUMH[o1] = fmaf(Pb, Hb1, Hb); }
        }
        __syncthreads();
    } else {
        float carry;
        { float s = 0.f, pt = 1.f;
          if (th == 0) {
#pragma unroll 8
              for (int jj = 0; jj < 16; ++jj) { const int j = 16 * hi + jj; const size_t o = ((size_t)(0 * 2 + b) * NSUM + j) * D + ch; float p_ = SUMP[o], h_ = SUMH[o]; if (j > c) { p_ = 1.f; h_ = 0.f; } s = fmaf(p_, s, h_); pt *= p_; }
              float s0, s1, p0, p1; both_halves(s, s0, s1); both_halves(pt, p0, p1); carry = fmaf(p1, s0, s1); }
          else {
#pragma unroll 8
              for (int jj = 0; jj < 16; ++jj) { const int j = 16 * hi + 16 - jj; const size_t o = ((size_t)(1 * 2 + b) * NSUM + j) * D + ch; float p_ = SUMP[o], h_ = SUMH[o]; if (j < c + 2) { p_ = 1.f; h_ = 0.f; } s = fmaf(p_, s, h_); pt *= p_; }
              float s0, s1, p0, p1; both_halves(s, s0, s1); both_halves(pt, p0, p1); carry = fmaf(p0, s1, s0); } }
        unsigned hp[4][8];
        float ls = 0.f;
#define PACK16(i, hv) do { _Pragma("unroll") for (int r = 0; r < 8; ++r) { typedef _Float16 h2_t __attribute__((ext_vector_type(2))); typedef float f2_t __attribute__((ext_vector_type(2))); \
            const f2_t v2_ = {(hv)[2 * r], (hv)[2 * r + 1]}; hp[i][r] = __builtin_bit_cast(unsigned, __builtin_convertvector(v2_, h2_t)); } } while (0)
        if (th == 0) { Consts C; load_consts(F, A, 0, n, cg, r32, hi, C);
#pragma unroll
            for (int i = 0; i < 4; ++i) { f32x16 P, H; tile_local<0>(AD, i, C, ident, P, H, ls, false); tile_chain<0>(P, H, hi, carry, P); PACK16(i, P); __builtin_amdgcn_sched_barrier(0); } }
        else { Consts C; load_consts(F, A, 1, n, cg, r32, hi, C);
#pragma unroll
            for (int i = 3; i >= 0; --i) { f32x16 P, H; tile_local<1>(AD, i, C, ident, P, H, ls, false); tile_chain<1>(P, H, hi, carry, P); PACK16(i, P); __builtin_amdgcn_sched_barrier(0); } }
#undef PACK16
        if (hi == 0) xch[(th * 4 + cg) * 32 + r32] = carry;
        __syncthreads();
        carry = xch[((1 - th) * 4 + cg) * 32 + r32];
        LAS unsigned char* obase = lds + OUT_OFF + (32 * T0 + 4 * hi) * 256 + (32 * cg + r32) * 2;
#define UNP16(i, r) ((float)(__builtin_bit_cast(__attribute__((ext_vector_type(2))) _Float16, hp[i][(r) >> 1])[(r) & 1]))
#define SCAN2_OUT(i, hv) do { _Pragma("unroll") for (int r = 0; r < 8; ++r) asm volatile("" : "+v"(hp[i][r]));   _Pragma("unroll") for (int r = 0; r < 16; ++r) \
            *(LAS bf16*)(obase + (32 * (i) + (r & 3) + 8 * (r >> 2)) * 256) = (bf16)(pg8::cvt_pk_bf16(UNP16(i, r) + (hv)[r], 0.f) & 0xffffu); } while (0)
        if (th == 0) { Consts C; load_consts(F, A, 1, n, cg, r32, hi, C);
#pragma unroll
            for (int i = 3; i >= 0; --i) { f32x16 P, H, h; tile_local<1>(AD, i, C, ident, P, H, ls, false); tile_chain<1>(P, H, hi, carry, h); SCAN2_OUT(i, h); __builtin_amdgcn_sched_barrier(0); } }
        else { Consts C; load_consts(F, A, 0, n, cg, r32, hi, C);
#pragma unroll
            for (int i = 0; i < 4; ++i) { f32x16 P, H, h; tile_local<0>(AD, i, C, ident, P, H, ls, false); tile_chain<0>(P, H, hi, carry, h); SCAN2_OUT(i, h); __builtin_amdgcn_sched_barrier(0); } }
#undef SCAN2_OUT
#undef UNP16
        __syncthreads();
        bf16* GY = (bf16*)(F.ws + WS_GY);
        int tid2 = tid; asm volatile("" : "+v"(tid2));
        const int q = tid2 & 15;
#pragma unroll
        for (int tt = tid2 >> 4; tt < 256; tt += 32) {
            const v4u hv = *(const LAS v4u*)(lds + OUT_OFF + tt * 256 + (q << 4));
            bf16* gp = GY + (size_t)(b * SEQ + 256 * c + tt) * D + 128 * n + 8 * q; const v4u g = *(const v4u*)gp; v4u o;
            o.x = pg8::cvt_pk_bf16(bflo(hv.x) * bflo(g.x), bfhi(hv.x) * bfhi(g.x)); o.y = pg8::cvt_pk_bf16(bflo(hv.y) * bflo(g.y), bfhi(hv.y) * bfhi(g.y));
            o.z = pg8::cvt_pk_bf16(bflo(hv.z) * bflo(g.z), bfhi(hv.z) * bfhi(g.z)); o.w = pg8::cvt_pk_bf16(bflo(hv.w) * bflo(g.w), bfhi(hv.w) * bfhi(g.w));
            *(v4u*)(dry ? (bf16*)F.out + (gp - GY) : gp) = o; }
        __syncthreads();
    }
}
template <bool FINAL> __device__ __forceinline__ void scan_phase(Frame& F, const Args& A, bool dry = false) {
    constexpr int NU = BATCH * 8 * NCH;
    for (int it = F.vcu; it < NU; it += F.G) { const int b = it / (8 * NCH), r = it % (8 * NCH), ci = r / 8, n = r % 8;
        for (int c = (!FINAL && ci == 0) ? -1 : ci; c <= ci; ++c) scan_unit<FINAL>(F, A, b, n, c, dry); }
}
}

namespace attn {
typedef float f32x16 __attribute__((ext_vector_type(16)));
typedef short s16x4 __attribute__((ext_vector_type(4)));
typedef __attribute__((address_space(3))) const char* lds_cptr;
constexpr int SHM = 16384, V_OFF = 0, K_OFF = 2 * SHM, WSC_OFF = 4 * SHM;
#define KSWZ(row, colB) ((row) * 256 + ((colB) ^ (((row) & 7) << 4)))
__device__ __forceinline__ int v_st(int k, int c) { const int kk = (k & ~0xC) | ((k & 4) << 1) | ((k & 8) >> 1); return ((kk >> 3) * 4 + (c >> 5)) * 512 + ((kk & 7) * 32 + (c & 31)) * 2; }
__device__ __forceinline__ int v_rd_base(int lane) { return ((lane & 3) << 3) | (((lane >> 2) & 3) << 6) | (((lane >> 4) & 1) << 5) | (((lane >> 5) & 1) << 8); }
constexpr int v_rd_off(int d0, int ks, int half) { return d0 * 512 + ks * 4096 + half * 2048; }
__device__ __forceinline__ int crow(int r, int hi) { return (r & 3) + 8 * (r >> 2) + 4 * hi; }
__device__ __forceinline__ s16x4 vtr(lds_cptr p) { typedef short v4i16_t __attribute__((ext_vector_type(4))); return __builtin_bit_cast(s16x4, __builtin_amdgcn_ds_read_tr16_b64_v4i16((__attribute__((address_space(3))) v4i16_t*)p)); }
template <int KB> __device__ __forceinline__ void qkt(f32x16& p0, f32x16& p1, lds_cptr K_lds, int r32, int hi, const bf16x8 (&qr)[8], bool second) {
    p0 = f32x16{}; p1 = f32x16{};
    lds_cptr kb[4];
#pragma unroll
    for (int dd = 0; dd < 4; ++dd) kb[dd] = K_lds + KB * SHM + KSWZ(r32, (dd * 16 + hi * 8) * 2);
#pragma unroll
    for (int d0 = 0; d0 < 8; ++d0) { lds_cptr a = kb[d0 & 3] + (d0 >> 2) * 128;
        const bf16x8 b0 = *(const LAS bf16x8*)a;
        p0 = __builtin_amdgcn_mfma_f32_32x32x16_bf16(b0, qr[d0], p0, 0, 0, 0);
        if (second) { const bf16x8 b1 = *(const LAS bf16x8*)(a + 32 * 256); p1 = __builtin_amdgcn_mfma_f32_32x32x16_bf16(b1, qr[d0], p1, 0, 0, 0); } }
}
template <int VB> __device__ __forceinline__ void pv_tile(f32x16 (&o)[4], int vb0, bf16x8 pa0, bf16x8 pa1, bf16x8 pa2, bf16x8 pa3, bool full) {
#define TRRD(dst, off) asm volatile("ds_read_b64_tr_b16 %0, %1 offset:%2" : "=&v"(dst) : "v"(vb0), "i"(off) : "memory")
#define PKV(l_, h_) (bf16x8){l_[0], l_[1], l_[2], l_[3], h_[0], h_[1], h_[2], h_[3]}
#define PV_D0(d0) do { s16x4 l0, l1, l2, l3, h0, h1, h2, h3; constexpr int b_ = VB * SHM + v_rd_off(d0, 0, 0); \
        TRRD(l0, b_); TRRD(h0, b_ + 2048); \
        if (full) { TRRD(l1, b_ + 4096); TRRD(h1, b_ + 6144); TRRD(l2, b_ + 8192); TRRD(h2, b_ + 10240); TRRD(l3, b_ + 12288); TRRD(h3, b_ + 14336); } \
        asm volatile("s_waitcnt lgkmcnt(0)" ::: "memory"); __builtin_amdgcn_sched_barrier(0); \
        o[d0] = __builtin_amdgcn_mfma_f32_32x32x16_bf16(pa0, PKV(l0, h0), o[d0], 0, 0, 0); \
        if (full) { o[d0] = __builtin_amdgcn_mfma_f32_32x32x16_bf16(pa1, PKV(l1, h1), o[d0], 0, 0, 0); \
                    o[d0] = __builtin_amdgcn_mfma_f32_32x32x16_bf16(pa2, PKV(l2, h2), o[d0], 0, 0, 0); \
                    o[d0] = __builtin_amdgcn_mfma_f32_32x32x16_bf16(pa3, PKV(l3, h3), o[d0], 0, 0, 0); } } while (0)
    PV_D0(0); PV_D0(1); PV_D0(2); PV_D0(3);
#undef PV_D0
#undef PKV
#undef TRRD
}
struct St { bf16x8 k0, k1, v0, v1; };
__device__ __forceinline__ void attn_unit(Frame& F, const float* sinkp, int b, int kv, int qb, bf16* Oout) {
    const int tid = F.tid, lane = F.lane, w = F.wave, r32 = lane & 31, hi = lane >> 5;
    const int h = 4 * kv + (w >> 1), s0 = 64 * qb, qlo = s0 + 32 * (w & 1), qpos = qlo + r32;
    bf16* Q = (bf16*)(F.ws + WS_Q); const bf16* Kb = (const bf16*)(F.ws + WS_K); const bf16* Vb = (const bf16*)(F.ws + WS_V);
    LAS unsigned char* lds = F.lds;
    lds_cptr K_lds = (lds_cptr)(lds + K_OFF); const int vp = (int)(uintptr_t)(lds + V_OFF) + v_rd_base(lane);
    LAS float* wsc = (LAS float*)(lds + WSC_OFF) + w * 64;
    const float slope2 = __builtin_amdgcn_exp2f(-(float)(h + 1)) * LOG2E;
    const int j_lo = s0 >= 128 ? 0 : (128 - s0) / 64, j_hi = (SEQ - s0 + 128) / 64 < 5 ? (SEQ - s0 + 128) / 64 : 5, NT = 1 + j_hi - j_lo;
    const int sr = tid >> 4, sc = (tid & 15) * 8, kws = KSWZ(sr, sc * 2), vst0 = v_st(sr, sc), vst1 = v_st(32 + sr, sc);
    const size_t kvcol = (size_t)kv * HD + sc;
    St st;
#define ST_LOAD(t) do { size_t ra_, rb_; if ((t) == 0) { ra_ = (size_t)(MREAL + (sr < 16 ? sr : 15)); rb_ = (size_t)(MREAL + 15); } \
        else { const int kb_ = s0 - 128 + 64 * (j_lo + (t) - 1); ra_ = (size_t)(b * SEQ + kb_ + sr); rb_ = ra_ + 32; } \
        st.k0 = *(const bf16x8*)(Kb + ra_ * KVW + kvcol); st.k1 = *(const bf16x8*)(Kb + rb_ * KVW + kvcol); st.v0 = *(const bf16x8*)(Vb + ra_ * KVW + kvcol); st.v1 = *(const bf16x8*)(Vb + rb_ * KVW + kvcol); } while (0)
#define ST_WRITE(bf) do { *(LAS bf16x8*)(lds + K_OFF + (bf) * SHM + kws) = st.k0; *(LAS bf16x8*)(lds + K_OFF + (bf) * SHM + kws + 32 * 256) = st.k1; \
        *(LAS bf16x8*)(lds + V_OFF + (bf) * SHM + vst0) = st.v0; *(LAS bf16x8*)(lds + V_OFF + (bf) * SHM + vst1) = st.v1; } while (0)
    ST_LOAD(0);
    bf16x8 qr[8];
    { const bf16* qp = Q + (size_t)(b * SEQ + qpos) * D + h * HD + hi * 8;
#pragma unroll
      for (int d0 = 0; d0 < 8; ++d0) qr[d0] = *(const bf16x8*)(qp + d0 * 16); }
    float m_reg = sinkp[h] * LOG2E, l_reg = 1.f;
    f32x16 o[4] = {};
    ST_WRITE(0);
    __syncthreads();
    for (int t = 0; t < NT; ++t) {
        f32x16 p0, p1;
        const bool band = t > 0;
        if (t & 1) qkt<1>(p0, p1, K_lds, r32, hi, qr, band); else qkt<0>(p0, p1, K_lds, r32, hi, qr, band);
        const float NEG = -__builtin_inff();
        if (!band) {
#pragma unroll
            for (int r = 8; r < 16; ++r) p0[r] = NEG;
#pragma unroll
            for (int r = 0; r < 16; ++r) p1[r] = NEG;
        } else {
            const int kb = s0 - 128 + 64 * (j_lo + t - 1);
            const float dqf = (float)(kb + 4 * hi - qpos);
            const bool need_mask = (kb + 63 > qlo + 128) || (kb < qlo + 31 - 128);
#pragma unroll
            for (int r = 0; r < 16; ++r) { const float c = (float)((r & 3) + 8 * (r >> 2)); const float d0 = fabsf(dqf + c), d1 = fabsf(dqf + c + 32.f);
                p0[r] = fmaf(-slope2, d0, p0[r]); p1[r] = fmaf(-slope2, d1, p1[r]);
                if (need_mask) { if (d0 > 128.f) p0[r] = NEG; if (d1 > 128.f) p1[r] = NEG; } }
        }
        float pmax = p0[0];
#pragma unroll
        for (int r = 1; r < 16; ++r) pmax = fmaxf(pmax, p0[r]);
#pragma unroll
        for (int r = 0; r < 16; ++r) pmax = fmaxf(pmax, p1[r]);
        { auto rr = __builtin_amdgcn_permlane32_swap(__float_as_uint(pmax), __float_as_uint(pmax), false, false); pmax = fmaxf(__uint_as_float(rr[0]), __uint_as_float(rr[1])); }
        const float mn = fmaxf(m_reg, pmax), alpha = __builtin_amdgcn_exp2f(m_reg - mn); m_reg = mn;
        float ps = 0.f;
#pragma unroll
        for (int r = 0; r < 16; ++r) { p0[r] = __builtin_amdgcn_exp2f(p0[r] - mn); p1[r] = __builtin_amdgcn_exp2f(p1[r] - mn); ps += p0[r] + p1[r]; }
        { auto rr = __builtin_amdgcn_permlane32_swap(__float_as_uint(ps), __float_as_uint(ps), false, false); ps = __uint_as_float(rr[0]) + __uint_as_float(rr[1]); }
        l_reg = l_reg * alpha + ps;
        bf16x8 pa0, pa1, pa2, pa3;
#define PK4(P, B_, OUT) do { const unsigned a0 = pg8::cvt_pk_bf16(P[B_ + 0], P[B_ + 1]), a1 = pg8::cvt_pk_bf16(P[B_ + 2], P[B_ + 3]), b0 = pg8::cvt_pk_bf16(P[B_ + 4], P[B_ + 5]), b1 = pg8::cvt_pk_bf16(P[B_ + 6], P[B_ + 7]); \
        auto r0 = __builtin_amdgcn_permlane32_swap(a0, b0, false, false); auto r1 = __builtin_amdgcn_permlane32_swap(a1, b1, false, false); \
        v4u w_ = {r0[0], r1[0], r0[1], r1[1]}; OUT = __builtin_bit_cast(bf16x8, w_); } while (0)
        PK4(p0, 0, pa0); PK4(p0, 8, pa1); PK4(p1, 0, pa2); PK4(p1, 8, pa3);
#undef PK4
        if (__any(alpha < 1.f)) { if (hi == 0) wsc[r32] = alpha; LDS_WAIT();
#pragma unroll
            for (int d_ = 0; d_ < 4; ++d_)
#pragma unroll
                for (int r = 0; r < 16; ++r) o[d_][r] *= wsc[crow(r, hi)];
            LDS_WAIT(); }
        if (t + 1 < NT) ST_LOAD(t + 1);
        __builtin_amdgcn_sched_barrier(0);
        if (t & 1) pv_tile<1>(o, vp, pa0, pa1, pa2, pa3, band); else pv_tile<0>(o, vp, pa0, pa1, pa2, pa3, band);
        if (t + 1 < NT) { if ((t + 1) & 1) ST_WRITE(1); else ST_WRITE(0); }
        __syncthreads();
    }
#undef ST_LOAD
#undef ST_WRITE
    { int l2 = lane; asm volatile("" : "+v"(l2)); const int e32 = l2 & 31, ehi = l2 >> 5;
      if (ehi == 0) wsc[32 + e32] = l_reg; LDS_WAIT();
      LAS bf16* stg = (LAS bf16*)(lds + w * 8192);
#pragma unroll
      for (int r = 0; r < 16; ++r) { const int orow = (r & 3) + 8 * (r >> 2); const float rl = __builtin_amdgcn_rcpf(wsc[32 + orow + 4 * ehi]);
#pragma unroll
          for (int d0 = 0; d0 < 4; ++d0) stg[(orow + 4 * ehi) * 128 + d0 * 32 + e32] = (bf16)(pg8::cvt_pk_bf16(o[d0][r] * rl, 0.f) & 0xffffu); }
      LDS_WAIT();
      bf16* Ow = Oout + (size_t)(b * SEQ + qlo) * D + h * HD;
      const unsigned eoff = (unsigned)((l2 >> 4) * D + (l2 & 15) * 8);
#pragma unroll
      for (int i = 0; i < 8; ++i) { const v4u v = *(const LAS v4u*)(stg + (i * 4 + (l2 >> 4)) * 128 + (l2 & 15) * 8); *(v4u*)(Ow + eoff + i * 4 * D) = v; }
      LDS_WAIT(); }
    __syncthreads();
}
__device__ __forceinline__ void attn_phase(Frame& F, const Args& A, bool dry = false) {
    for (int it = F.vcu; it < BATCH * NKV * (SEQ / 64); it += F.G) { const int bk = it / (SEQ / 64), qb = it % (SEQ / 64); attn_unit(F, A.in[I_SINK], bk >> 1, bk & 1, qb, dry ? (bf16*)F.out : (bf16*)(F.ws + WS_Q)); }
}
#undef KSWZ
}

constexpr int NPHASE = 10;
#ifndef REP_BAR
#define REP_BAR 0
#endif
#ifndef REP_ROUTE2
#define REP_ROUTE2 0
#endif
#ifndef REP_P0A
#define REP_P0A 0
#endif
#ifndef REP_P1
#define REP_P1 0
#endif
#ifndef REP_P0B
#define REP_P0B 0
#endif
#ifndef REP_S1
#define REP_S1 0
#endif
#ifndef REP_ATTN
#define REP_ATTN 0
#endif
#ifndef REP_S3
#define REP_S3 0
#endif
#ifndef REP_MERGE
#define REP_MERGE 0
#endif
#ifndef REP_WOUT
#define REP_WOUT 0
#endif
#ifndef REP_ROUTE
#define REP_ROUTE 0
#endif
#ifndef REP_MOE1
#define REP_MOE1 0
#endif
#ifndef REP_MOE2
#define REP_MOE2 0
#endif
#ifndef REP_FINAL
#define REP_FINAL 0
#endif

#ifndef FAST_ROUTE
#define FAST_ROUTE 1
#endif
#ifndef FAST_ATTN
#define FAST_ATTN 1
#endif
#ifndef FAST_SCAN
#define FAST_SCAN 2
#endif
#ifndef P1_LO
#define P1_LO 112
#define P1_HI 176
#endif
#ifndef FAST_P1
#define FAST_P1 1
#endif
#ifndef FAST_MERGE
#define FAST_MERGE 1
#endif
#ifndef FAST_WOUT
#define FAST_WOUT 1
#endif
#ifndef FAST_MOE
#define FAST_MOE 1
#endif
__global__ void __launch_bounds__(NTHREADS, 2) mega_fwd(Args args) {
    extern __shared__ __attribute__((aligned(16))) unsigned char lds[];
    Frame F;
    F.lds = (LAS unsigned char*)lds;
    F.MISC = (volatile LAS unsigned*)(F.lds + MISC_OFF);
    F.tid = threadIdx.x; F.lane = F.tid & 63; F.wave = __builtin_amdgcn_readfirstlane(F.tid >> 6);
    F.G = gridDim.x; { const int bx = blockIdx.x; F.vcu = (F.G % 8 == 0) ? (bx % 8) * (F.G / 8) + bx / 8 : bx; }
    F.ws = args.ws; F.out = args.out; F.ctl = (gu32*)(args.ws + WS_CTL);
    for (int u = F.tid; u < (LDS_BYTES - LDSCTL_OFF) / 4; u += NTHREADS) ((LAS unsigned*)(F.lds + LDSCTL_OFF))[u] = 0u;
    __syncthreads();
    XcdBarrier bar; bar.bar = (unsigned*)(F.ctl + CW_BAR); bar.x = 0; bar.st = nullptr;
    if (args.use_bar) bar = xcd_barrier_post((unsigned*)(F.ctl + CW_BAR), F.MISC + 8);
    const int lo = args.ph_lo, hi = args.ph_hi;
#define IN(k) (lo <= (k) && (k) < hi && (refresh(F), true))
#define SEAM(k) do { if (lo <= (k) && (k) + 1 < hi) { for (int rb_ = 0; rb_ < REP_BAR; ++rb_) xcd_barrier(bar); xcd_barrier(bar); } } while (0)
#define REPEAT(n, stmt) do { for (int rep_ = 0; rep_ < (n); ++rep_) { stmt; __syncthreads(); } } while (0)
    if (IN(0)) { REPEAT(REP_P0A, p0_prologue<0>(F, args)); p0_prologue<0>(F, args); } SEAM(0);
    if (IN(1)) { REPEAT(REP_P1, p1_fast(F, args)); if (FAST_P1) p1_fast(F, args); else p1_simple(F, args); } SEAM(1);
    if (IN(2)) { REPEAT(REP_P0B, p0_prologue<1>(F, args)); p0_prologue<1>(F, args); __syncthreads();
                 REPEAT(REP_S1, scan2::scan_phase<false>(F, args)); if (FAST_SCAN == 2) scan2::scan_phase<false>(F, args); else if (FAST_SCAN) scan::scan_phase<false>(F, args); else scan_simple(F, args);
                 REPEAT(REP_ATTN, attn::attn_phase(F, args, true)); if (FAST_ATTN) attn::attn_phase(F, args); else attn_simple(F, args); } SEAM(2);
    if (IN(3)) { REPEAT(REP_S3, scan2::scan_phase<true>(F, args, true)); if (FAST_SCAN == 2) scan2::scan_phase<true>(F, args); else if (FAST_SCAN) scan::scan_phase<true>(F, args); } SEAM(3);
    if (IN(4)) { REPEAT(REP_MERGE, merge_fast(F, args)); if (FAST_MERGE) merge_fast(F, args); else merge_simple(F, args); } SEAM(4);
    if (IN(5)) { REPEAT(REP_WOUT, wout_fast(F, args)); if (FAST_WOUT) wout_fast(F, args); else wout_simple(F, args); } SEAM(5);
    if (IN(6)) { REPEAT(REP_ROUTE, route_simple(F, args, true)); REPEAT(REP_ROUTE2, route_fast(F, args, true)); if (FAST_ROUTE) route_fast(F, args); else route_simple(F, args); } SEAM(6);
    if (IN(7)) { REPEAT(REP_MOE1, moe1_fast(F, args)); if (FAST_MOE) moe1_fast(F, args); else moe1_simple(F, args); } SEAM(7);
    if (IN(8)) { REPEAT(REP_MOE2, moe2_fast(F, args)); if (FAST_MOE) moe2_fast(F, args); else moe2_simple(F, args); } SEAM(8);
    if (IN(9)) { REPEAT(REP_FINAL, final_rows(F, args, true)); final_rows(F, args); }
#undef IN
#undef SEAM
}

#ifndef MK_N_LAUNCHES
#define MK_N_LAUNCHES 1
#endif
extern "C" void kernel_launch(void* const* d_in, const int* in_sizes, int n_in, void* d_out, int out_size, void* d_ws, size_t ws_size, hipStream_t stream) {
    static int grid = 0;
    if (grid == 0) {
        if (n_in != 24 || in_sizes[0] != MREAL * D || out_size != MREAL * D || ws_size < WS_END) {
            fprintf(stderr, "kernel_launch: unexpected shapes: n_in %d in0 %d out %d ws %zu (need %zu)\n", n_in, n_in > 0 ? in_sizes[0] : -1, out_size, ws_size, (size_t)WS_END); grid = -1; return; }
        int dev = 0, cus = 0, per_cu = 0;
        if (hipGetDevice(&dev) != hipSuccess || hipDeviceGetAttribute(&cus, hipDeviceAttributeMultiprocessorCount, dev) != hipSuccess) { grid = -1; return; }
        if (hipFuncSetAttribute((const void*)mega_fwd, hipFuncAttributeMaxDynamicSharedMemorySize, LDS_BYTES) != hipSuccess) { fprintf(stderr, "kernel_launch: hipFuncSetAttribute failed\n"); grid = -1; return; }
        if (hipOccupancyMaxActiveBlocksPerMultiprocessor(&per_cu, (const void*)mega_fwd, NTHREADS, LDS_BYTES) != hipSuccess || per_cu < 1) {
            fprintf(stderr, "kernel_launch: occupancy query says %d blocks per CU\n", per_cu); (void)hipGetLastError(); }
        grid = cus;
    }
    if (grid < 0) return;
    (void)hipMemsetAsync((char*)d_ws + WS_CTL, 0, CTL_ZERO_BYTES, stream);
    Args a{};
    for (int i = 0; i < 24; ++i) a.in[i] = (const float*)d_in[i];
    a.out = (float*)d_out; a.ws = (unsigned char*)d_ws;
    if (MK_N_LAUNCHES == 1) { a.ph_lo = 0; a.ph_hi = NPHASE; a.use_bar = 1; hipLaunchKernelGGL(mega_fwd, dim3(grid), dim3(NTHREADS), LDS_BYTES, stream, a); }
    else for (int p = 0; p < NPHASE; ++p) { a.ph_lo = p; a.ph_hi = p + 1; a.use_bar = 0; hipLaunchKernelGGL(mega_fwd, dim3(grid), dim3(NTHREADS), LDS_BYTES, stream, a); }
}
```
